# Optimizing an MI355X kernel written in HIP

```python
import math
import jax, jax.numpy as jnp
from jax import lax
import numpy as np

D_MODEL = 1024
BATCH = 2
SEQ = 8192
DEPTH = 1

BLOCK = 128
N_META = 16
N_LEAD = BLOCK
FIRST_VALID = N_LEAD - N_META
HEAD_DIM = 64
BRANCH_WIDTH = D_MODEL // 2
N_BRANCH = 2
SB_HEADS = BRANCH_WIDTH // HEAD_DIM
SW_HEADS = BRANCH_WIDTH // HEAD_DIM
SW_KV_HEADS = 2
SW_GROUP = SW_HEADS // SW_KV_HEADS
SW_KV_WIDTH = SW_KV_HEADS * HEAD_DIM
WINDOW = 128
N_BUCKETS = 32
MAX_DISTANCE = 128
RMS_EPS = 1e-6
SPLIT_SIZES = (
    BRANCH_WIDTH, BRANCH_WIDTH, BRANCH_WIDTH, BRANCH_WIDTH,
    BRANCH_WIDTH, SW_KV_WIDTH, SW_KV_WIDTH, BRANCH_WIDTH,
    N_BRANCH * D_MODEL,
)
PROJ_WIDTH = sum(SPLIT_SIZES)
SPLIT_POINTS = tuple(int(i) for i in np.cumsum(SPLIT_SIZES)[:-1])

kernel_name = "hybrid_stickbreak_swa_sink_block"


def _rmsnorm(x, w):
    xf = x.astype(jnp.float32)
    xf = xf * lax.rsqrt(jnp.mean(xf * xf, axis=-1, keepdims=True) + RMS_EPS)
    return (xf * w.astype(jnp.float32)).astype(x.dtype)


def _t5_buckets(rel):
    n = np.maximum(rel, 0)
    max_exact = N_BUCKETS // 2
    large = max_exact + (np.log(np.maximum(n, 1) / max_exact)
                         / math.log(MAX_DISTANCE / max_exact)
                         * (N_BUCKETS - max_exact)).astype(np.int32)
    large = np.minimum(large, N_BUCKETS - 1)
    return np.where(n < max_exact, n, large).astype(np.int32)


def _stick_breaking(q, k, v):
    b, h, lp, dh = q.shape
    nb = lp // BLOCK
    kpos = jnp.arange(lp)
    key_ok = kpos >= FIRST_VALID
    scale = dh ** -0.5
    qblocks = q.reshape(b, h, nb, BLOCK, dh).transpose(2, 0, 1, 3, 4)
    qpos = jnp.arange(lp).reshape(nb, BLOCK)

    def one_block(args):
        qb, qp = args
        z = jnp.einsum('bhqd,bhkd->bhqk', qb, k, preferred_element_type=jnp.float32) * scale
        visible = (kpos[None, :] < qp[:, None]) & key_ok[None, :]
        log_1m = jnp.where(visible, jax.nn.log_sigmoid(-z), 0.0)
        later = lax.cumsum(log_1m, axis=3, reverse=True) - log_1m
        w = jnp.where(visible, jnp.exp(jax.nn.log_sigmoid(z) + later), 0.0)
        return jnp.einsum('bhqk,bhkd->bhqd', w.astype(v.dtype), v,
                          preferred_element_type=jnp.float32)

    out = lax.map(one_block, (qblocks, qpos))
    return out.transpose(1, 2, 0, 3, 4).reshape(b, h, lp, dh)


def _sliding_window_gqa(q, k, v, q_gain, k_gain, sinks, rel_bias):
    b, _, lp, dh = q.shape
    nb = lp // BLOCK
    q = _rmsnorm(q, q_gain)
    k = _rmsnorm(k, k_gain)
    qb = q.reshape(b, SW_KV_HEADS, SW_GROUP, nb, BLOCK, dh)

    def band(t):
        t = jnp.pad(t, ((0, 0), (0, 0), (BLOCK, 0), (0, 0))).reshape(b, SW_KV_HEADS, nb + 1, BLOCK, dh)
        return jnp.concatenate([t[:, :, :-1], t[:, :, 1:]], axis=3)

    kb, vb = band(k), band(v)
    logits = jnp.einsum('bkgnqd,bknsd->bkgnqs', qb, kb,
                        preferred_element_type=jnp.float32) * dh ** -0.5
    rel = (BLOCK + np.arange(BLOCK))[:, None] - np.arange(2 * BLOCK)[None, :]
    bias = rel_bias.astype(jnp.float32)[_t5_buckets(rel)]
    bias = jnp.transpose(bias, (2, 0, 1)).reshape(SW_KV_HEADS, SW_GROUP, 1, BLOCK, 2 * BLOCK)
    kpos = (np.arange(nb)[:, None, None] * BLOCK - BLOCK + np.arange(2 * BLOCK)[None, None, :])
    visible = (rel >= 0)[None] & (rel < WINDOW)[None] & (kpos >= FIRST_VALID)
    logits = jnp.where(visible, logits + bias, -jnp.inf)
    sink = sinks.astype(jnp.float32).reshape(SW_KV_HEADS, SW_GROUP, 1, 1, 1)
    m = jnp.maximum(jnp.max(logits, axis=-1, keepdims=True), sink)
    p = jnp.exp(logits - m)
    denom = jnp.sum(p, axis=-1, keepdims=True) + jnp.exp(sink - m)
    out = jnp.einsum('bkgnqs,bknsd->bkgnqd', (p / denom).astype(v.dtype), vb,
                     preferred_element_type=jnp.float32)
    return out.reshape(b, SW_HEADS, lp, dh)


def _heads(t, n):
    b, l, _ = t.shape
    return t.reshape(b, l, n, HEAD_DIM).transpose(0, 2, 1, 3)


def _merge_heads(t):
    b, h, l, d = t.shape
    return t.transpose(0, 2, 1, 3).reshape(b, l, h * d)


def _layer(x, norm_w, w_in, q_gain, k_gain, sinks, w_branch, w_out, rel_bias):
    b, lp, _ = x.shape
    xn = _rmsnorm(x, norm_w)
    proj = jnp.einsum('bld,dp->blp', xn, w_in)
    qa, ka, va, za, qbq, kbk, vbv, zb, gates = jnp.split(proj, SPLIT_POINTS, axis=-1)
    oa = _merge_heads(_stick_breaking(_heads(qa, SB_HEADS), _heads(ka, SB_HEADS),
                                      _heads(va, SB_HEADS))).astype(x.dtype)
    ob = _merge_heads(_sliding_window_gqa(_heads(qbq, SW_HEADS), _heads(kbk, SW_KV_HEADS),
                                          _heads(vbv, SW_KV_HEADS), q_gain, k_gain,
                                          sinks, rel_bias)).astype(x.dtype)
    branches = jnp.stack([oa * jax.nn.silu(za), ob * jax.nn.silu(zb)], axis=2)
    y = jnp.einsum('blgc,gcd->blgd', branches, w_branch)
    g = jax.nn.sigmoid(gates.reshape(b, lp, N_BRANCH, D_MODEL))
    merged = jnp.sum(g * y, axis=2)
    return x + jnp.einsum('bld,de->ble', merged, w_out)


def setup_inputs(seed: int = 0) -> dict:
    key = jax.random.key(seed)
    ks = jax.random.split(key, 11)
    f32 = jnp.float32
    x = jax.random.normal(ks[0], (BATCH, SEQ, D_MODEL), f32)
    meta = jax.random.normal(ks[1], (N_META, D_MODEL), f32)
    rel_bias = 0.5 * jax.random.normal(ks[2], (N_BUCKETS, SW_HEADS), f32)
    norm_w = 1.0 + 0.05 * jax.random.normal(ks[3], (DEPTH, D_MODEL), f32)
    w_in = jax.random.normal(ks[4], (DEPTH, D_MODEL, PROJ_WIDTH), f32) * D_MODEL ** -0.5
    q_gain = 1.0 + 0.05 * jax.random.normal(ks[5], (DEPTH, HEAD_DIM), f32)
    k_gain = 1.0 + 0.05 * jax.random.normal(ks[6], (DEPTH, HEAD_DIM), f32)
    sinks = 0.5 * jax.random.normal(ks[7], (DEPTH, SW_HEADS), f32)
    w_branch = jax.random.normal(ks[8], (DEPTH, N_BRANCH, BRANCH_WIDTH, D_MODEL), f32) * BRANCH_WIDTH ** -0.5
    w_out = jax.random.normal(ks[9], (DEPTH, D_MODEL, D_MODEL), f32) * D_MODEL ** -0.5
    return {"x": x, "meta": meta, "rel_bias": rel_bias, "norm_w": norm_w, "w_in": w_in,
            "q_gain": q_gain, "k_gain": k_gain, "sinks": sinks, "w_branch": w_branch,
            "w_out": w_out}


def reference(x, meta, rel_bias, norm_w, w_in, q_gain, k_gain, sinks, w_branch, w_out):
    b = x.shape[0]
    pad = jnp.zeros((b, FIRST_VALID, D_MODEL), x.dtype)
    h = jnp.concatenate([pad, jnp.broadcast_to(meta.astype(x.dtype)[None], (b, N_META, D_MODEL)), x], axis=1)
    for layer in range(DEPTH):
        h = _layer(h, norm_w[layer], w_in[layer], q_gain[layer], k_gain[layer], sinks[layer],
                   w_branch[layer], w_out[layer], rel_bias)
    return h[:, N_LEAD:].astype(x.dtype)
```

```cpp
#include <hip/hip_runtime.h>
#include <cstdio>
#include <cstdint>

#ifndef MK_N_LAUNCHES
#define MK_N_LAUNCHES 1
#endif
#define DUP_PHASE -1

constexpr int BATCH = 2, SEQ = 8192, DM = 1024;
constexpr int LP = SEQ + 128;
constexpr int MP = BATCH * LP;
constexpr int MR = BATCH * SEQ;
constexpr int NPROJ1 = 3328;
constexpr int NGATE = 2048;
constexpr int NPROJ = NPROJ1 + NGATE;
constexpr float RMS_EPS = 1e-6f;
constexpr float LOG2E = 1.4426950408889634f;
constexpr float QSCALE = 0.125f * LOG2E;
constexpr float SB_EPS = 1e-13f;
constexpr int BT_LD = 192;

namespace pg8 {
#define PG8_LAS __attribute__((address_space(3)))
typedef unsigned short bf16_t;
typedef short bf16x8 __attribute__((ext_vector_type(8)));
typedef float f32x4 __attribute__((ext_vector_type(4)));
typedef unsigned u32x4 __attribute__((ext_vector_type(4)));
constexpr int BM = 256, BK = 64, HALF = 128, HTB = HALF * BK * 2  , STAGE_BYTES = 8 * HTB, NXCD = 8, WGM = 8;

__host__ __device__ __forceinline__ int lds_byte(int r, int c) { const int st = (r >> 4) * 2 + (c >> 5), rr = r & 15, cc = c & 31, ob = rr * 64 + cc * 2; return st * 1024 + (ob ^ (((ob >> 9) & 1) << 5)); }
__host__ __device__ __forceinline__ void stage_rc(int b, int& R, int& C) { const int st = b / 1024, sb = b % 1024, swz = sb ^ (((sb >> 9) & 1) << 5); R = (st >> 1) * 16 + swz / 64; C = (st & 1) * 32 + (swz % 64) / 2; }
__host__ __device__ __forceinline__ int perm32(int rho) { const int n = rho >> 4, i = rho & 15; return 8 * (i >> 2) + 4 * n + (i & 3); }

struct Unit { int pm, pn; };
struct Gemm { const bf16_t* A; const bf16_t* Bt; int M, N, K, a_skip; };

struct StaticOrder {
    int nM, nN, nwg, G, c;
    __host__ __device__ void init(int M, int N, int G_, int c_) { nM = M / BM; nN = N / BM; nwg = nM * nN; G = G_; c = c_; }
    __host__ __device__ bool next(int i, Unit& u) const {
        const long L = (long)i * G + c; if (L >= nwg) return false;
        int wgid = (int)L; { const int q = nwg / NXCD, r = nwg % NXCD, xcd = wgid % NXCD, off = wgid / NXCD; wgid = (xcd < r ? xcd * (q + 1) : r * (q + 1) + (xcd - r) * q) + off; }
        const int nig = WGM * nN, gid = wgid / nig, fm = gid * WGM, gsz = (nM - fm) < WGM ? (nM - fm) : WGM;
        u.pm = fm + ((wgid % nig) % gsz); u.pn = (wgid % nig) / gsz; return true;
    }
    __device__ __forceinline__ void a_ready(const Unit&) const {}
    __device__ __forceinline__ void done(const Unit&) const {}
};

struct ListOrder {
    int nM, nN0, nN1, G, c, f0, f1;
    __host__ __device__ static void smap(int nM, int nN, int L, Unit& u) {
        const int nwg = nM * nN; int wgid = L; { const int q = nwg / NXCD, r = nwg % NXCD, xcd = wgid % NXCD, off = wgid / NXCD; wgid = (xcd < r ? xcd * (q + 1) : r * (q + 1) + (xcd - r) * q) + off; }
        const int nig = WGM * nN, gid = wgid / nig, fm = gid * WGM, gsz = (nM - fm) < WGM ? (nM - fm) : WGM;
        u.pm = fm + ((wgid % nig) % gsz); u.pn = (wgid % nig) / gsz;
    }
    __host__ __device__ bool next(int i, Unit& u) const {
        const int f = f0 + c + i * G; if (f >= f1) return false;
        const int n0 = nM * nN0;
        if (f < n0) smap(nM, nN0, f, u); else { smap(nM, nN1, f - n0, u); u.pn += nN0; }
        return true;
    }
    __device__ __forceinline__ void a_ready(const Unit&) const {}
    __device__ __forceinline__ void done(const Unit&) const {}
};

typedef float f32x2_t __attribute__((ext_vector_type(2))); typedef __bf16 bf16x2_t __attribute__((ext_vector_type(2)));
__device__ __forceinline__ unsigned cvt_pk_bf16(float lo, float hi) { f32x2_t v = {lo, hi}; bf16x2_t b = __builtin_convertvector(v, bf16x2_t); return __builtin_bit_cast(unsigned, b); }
__device__ __forceinline__ float bf_lo(unsigned w) { return __uint_as_float(w << 16); }
__device__ __forceinline__ float bf_hi(unsigned w) { return __uint_as_float(w & 0xffff0000u); }
__device__ __forceinline__ float sigmoidf_fast(float v) { return __builtin_amdgcn_rcpf(1.0f + __builtin_amdgcn_exp2f(-v * LOG2E)); }


struct EpiProj {
    static constexpr bool PERM = true, AFTER_DRAIN = false, MID = false, INIT = false;
    bf16_t *QA, *KA, *VA, *SZ, *QB, *KB, *VB, *GS; const float* qgain; const float* kgain;
    __device__ __forceinline__ void mid(f32x4 (&)[2][2][4][2], const Unit&, int, int, int, int) const {}
    __device__ __forceinline__ void operator()(const f32x4 (&acc)[2][2][4][2], const Unit& u, int wr, int wc, int fr, int fq) const {
        const int pn = u.pn;
        int kind; bf16_t* base = nullptr; int head = 0, H = 8; float sc = 1.f; const float* gain = nullptr;
        if (pn < 2)       { kind = 0; base = QA; head = 4 * pn + wc; sc = QSCALE; }
        else if (pn < 4)  { kind = 0; base = KA; head = 4 * (pn - 2) + wc; }
        else if (pn < 6)  { kind = 0; base = VA; head = 4 * (pn - 4) + wc; }
        else if (pn < 8)  { kind = 1; base = SZ; head = 4 * (pn - 6) + wc; H = 16; }
        else if (pn < 10) { kind = 2; base = QB; head = 4 * (pn - 8) + wc; gain = qgain; sc = QSCALE; }
        else if (pn == 10) { H = 2; if (wc < 2) { kind = 2; base = KB; head = wc; gain = kgain; } else { kind = 0; base = VB; head = wc - 2; } }
        else if (pn < 13) { kind = 1; base = SZ; head = 8 + 4 * (pn - 11) + wc; H = 16; }
        else              { kind = 4; base = GS; }
        kind = __builtin_amdgcn_readfirstlane(kind);
#pragma unroll
        for (int ai = 0; ai < 2; ++ai)
#pragma unroll
            for (int m = 0; m < 4; ++m) {
                const int row = u.pm * BM + ai * HALF + wr * 64 + m * 16 + fr;
                const int b = row >= LP ? 1 : 0, pos = row - b * LP;
                f32x4 v[2][2];
#pragma unroll
                for (int bj = 0; bj < 2; ++bj)
#pragma unroll
                    for (int n = 0; n < 2; ++n) v[bj][n] = acc[ai][bj][m][n];
                bf16_t* rowp;
                if (kind == 4) {
                    rowp = (bf16_t*)((char*)base + (unsigned)(((b * SEQ + pos - 128) * NGATE + 256 * (pn - 13) + 64 * wc + 8 * fq) * 2));
#pragma unroll
                    for (int bj = 0; bj < 2; ++bj)
#pragma unroll
                        for (int n = 0; n < 2; ++n)
#pragma unroll
                            for (int e = 0; e < 4; ++e) v[bj][n][e] = fmaxf(sigmoidf_fast(v[bj][n][e]), 1e-30f);
                } else {
                    rowp = (bf16_t*)((char*)base + (unsigned)((((b * H + head) * LP + pos) * 64 + 8 * fq) * 2));
                    if (kind == 1) {
#pragma unroll
                        for (int bj = 0; bj < 2; ++bj)
#pragma unroll
                            for (int n = 0; n < 2; ++n)
#pragma unroll
                                for (int e = 0; e < 4; ++e) { const float x = v[bj][n][e]; v[bj][n][e] = x * sigmoidf_fast(x); }
                    } else if (kind == 2) {
                        float ss = 0.f;
#pragma unroll
                        for (int bj = 0; bj < 2; ++bj)
#pragma unroll
                            for (int n = 0; n < 2; ++n) { const f32x4 x = v[bj][n]; ss += (x[0] * x[0] + x[1] * x[1]) + (x[2] * x[2] + x[3] * x[3]); }
                        ss += __shfl_xor(ss, 16); ss += __shfl_xor(ss, 32);
                        const float inv = sc / sqrtf(ss * (1.0f / 64.0f) + RMS_EPS);
#pragma unroll
                        for (int bj = 0; bj < 2; ++bj)
#pragma unroll
                            for (int n = 0; n < 2; ++n) v[bj][n] = v[bj][n] * *(const f32x4*)(gain + 32 * bj + 8 * fq + 4 * n) * inv;
                    } else {
#pragma unroll
                        for (int bj = 0; bj < 2; ++bj)
#pragma unroll
                            for (int n = 0; n < 2; ++n) v[bj][n] = v[bj][n] * sc;
                    }
                }
                if (kind != 4 || pos >= 128) {
#pragma unroll
                    for (int bj = 0; bj < 2; ++bj) {
                        u32x4 w; w.x = cvt_pk_bf16(v[bj][0][0], v[bj][0][1]); w.y = cvt_pk_bf16(v[bj][0][2], v[bj][0][3]); w.z = cvt_pk_bf16(v[bj][1][0], v[bj][1][1]); w.w = cvt_pk_bf16(v[bj][1][2], v[bj][1][3]);
                        __builtin_nontemporal_store(w, (u32x4*)(rowp + 32 * bj));
                    }
                }
            }
    }
};

struct EpiMerge {
    static constexpr bool PERM = true, AFTER_DRAIN = false, MID = true, INIT = false;
    const bf16_t* GS; bf16_t* MG;
    __device__ __forceinline__ void mid(f32x4 (&acc)[2][2][4][2], const Unit& u, int wr, int wc, int fr, int fq) const {
        const int colbase = 256 * u.pn + 64 * wc + 8 * fq;
#pragma unroll
        for (int ai = 0; ai < 2; ++ai)
#pragma unroll
            for (int m = 0; m < 4; ++m) {
                const int row = u.pm * BM + ai * HALF + wr * 64 + m * 16 + fr;
                const bf16_t* gp = (const bf16_t*)((const char*)GS + (unsigned)((row * NGATE + colbase) * 2));
#pragma unroll
                for (int bj = 0; bj < 2; ++bj) {
                    const u32x4 ga = *(const u32x4*)(gp + 32 * bj), gb = *(const u32x4*)(gp + 1024 + 32 * bj);
                    acc[ai][bj][m][0][0] *= bf_lo(ga.x) * __builtin_amdgcn_rcpf(bf_lo(gb.x)); acc[ai][bj][m][0][1] *= bf_hi(ga.x) * __builtin_amdgcn_rcpf(bf_hi(gb.x));
                    acc[ai][bj][m][0][2] *= bf_lo(ga.y) * __builtin_amdgcn_rcpf(bf_lo(gb.y)); acc[ai][bj][m][0][3] *= bf_hi(ga.y) * __builtin_amdgcn_rcpf(bf_hi(gb.y));
                    acc[ai][bj][m][1][0] *= bf_lo(ga.z) * __builtin_amdgcn_rcpf(bf_lo(gb.z)); acc[ai][bj][m][1][1] *= bf_hi(ga.z) * __builtin_amdgcn_rcpf(bf_hi(gb.z));
                    acc[ai][bj][m][1][2] *= bf_lo(ga.w) * __builtin_amdgcn_rcpf(bf_lo(gb.w)); acc[ai][bj][m][1][3] *= bf_hi(ga.w) * __builtin_amdgcn_rcpf(bf_hi(gb.w));
                }
            }
    }
    __device__ __forceinline__ void operator()(const f32x4 (&acc)[2][2][4][2], const Unit& u, int wr, int wc, int fr, int fq) const {
        const int colbase = 256 * u.pn + 64 * wc + 8 * fq;
#pragma unroll
        for (int ai = 0; ai < 2; ++ai)
#pragma unroll
            for (int m = 0; m < 4; ++m) {
                const int row = u.pm * BM + ai * HALF + wr * 64 + m * 16 + fr;
                const bf16_t* gp = (const bf16_t*)((const char*)GS + (unsigned)((row * NGATE + 1024 + colbase) * 2));
                bf16_t* rowp = (bf16_t*)((char*)MG + (unsigned)((row * DM + colbase) * 2));
#pragma unroll
                for (int bj = 0; bj < 2; ++bj) {
                    const u32x4 gb = *(const u32x4*)(gp + 32 * bj);
                    u32x4 w;
                    w.x = cvt_pk_bf16(acc[ai][bj][m][0][0] * bf_lo(gb.x), acc[ai][bj][m][0][1] * bf_hi(gb.x));
                    w.y = cvt_pk_bf16(acc[ai][bj][m][0][2] * bf_lo(gb.y), acc[ai][bj][m][0][3] * bf_hi(gb.y));
                    w.z = cvt_pk_bf16(acc[ai][bj][m][1][0] * bf_lo(gb.z), acc[ai][bj][m][1][1] * bf_hi(gb.z));
                    w.w = cvt_pk_bf16(acc[ai][bj][m][1][2] * bf_lo(gb.w), acc[ai][bj][m][1][3] * bf_hi(gb.w));
                    *(u32x4*)(rowp + 32 * bj) = w;
                }
            }
    }
};

struct EpiOut {
    static constexpr bool PERM = false, AFTER_DRAIN = false, MID = false, INIT = true;
    const float* X; float* O;
    __device__ __forceinline__ void mid(f32x4 (&)[2][2][4][2], const Unit&, int, int, int, int) const {}
    __device__ __forceinline__ void init(f32x4 (&acc)[2][2][4][2], const Unit& u, int wr, int wc, int fr, int fq) const {
        const int colbase = 256 * u.pn + 64 * wc + 4 * fq;
#pragma unroll
        for (int ai = 0; ai < 2; ++ai)
#pragma unroll
            for (int m = 0; m < 4; ++m) {
                const unsigned off = (unsigned)(((u.pm * BM + ai * HALF + wr * 64 + m * 16 + fr) * DM + colbase) * 4);
#pragma unroll
                for (int bj = 0; bj < 2; ++bj)
#pragma unroll
                    for (int n = 0; n < 2; ++n) acc[ai][bj][m][n] = __builtin_nontemporal_load((const f32x4*)((const char*)X + off + (32 * bj + 16 * n) * 4));
            }
    }
    __device__ __forceinline__ void operator()(const f32x4 (&acc)[2][2][4][2], const Unit& u, int wr, int wc, int fr, int fq) const {
        const int colbase = 256 * u.pn + 64 * wc + 4 * fq;
#pragma unroll
        for (int ai = 0; ai < 2; ++ai)
#pragma unroll
            for (int m = 0; m < 4; ++m) {
                const unsigned off = (unsigned)(((u.pm * BM + ai * HALF + wr * 64 + m * 16 + fr) * DM + colbase) * 4);
#pragma unroll
                for (int bj = 0; bj < 2; ++bj)
#pragma unroll
                    for (int n = 0; n < 2; ++n) __builtin_nontemporal_store(acc[ai][bj][m][n], (f32x4*)((char*)O + off + (32 * bj + 16 * n) * 4));
            }
    }
};

template <class Epi, class Sched, bool ALIGN_EPI = false, bool SP2 = false>
__device__ __forceinline__ void gemm_phase(PG8_LAS unsigned char* lds, const Gemm g, const Sched& S, const Epi& E, int wid  ) {
    const int lane = (int)__builtin_amdgcn_mbcnt_hi(~0u, __builtin_amdgcn_mbcnt_lo(~0u, 0u)), tid = wid * 64 + lane, wr = wid >> 2, wc = wid & 3, fr = lane & 15, fq = lane >> 4;
    const int K = g.K, nt = K / BK;
    unsigned voffA[2], voffB[2];
#pragma unroll
    for (int i = 0; i < 2; ++i) { int R, C; stage_rc(tid * 16 + i * 8192, R, C); const int Rb = Epi::PERM ? ((R & ~31) + perm32(R & 31)) : R;
        voffA[i] = (unsigned)(R * K + C) * 2u; voffB[i] = (unsigned)(Rb * K + C) * 2u; }
    const size_t kstep = (size_t)(BK * 2);
    const size_t hstep = (size_t)HALF * K * 2;
    const size_t tstep = 2 * hstep;
    const size_t rstep = (size_t)K * 2;
    const unsigned ldsw = (unsigned)wid * 1024u;
    const int aoff = lds_byte(wr * 64 + fr, fq * 8), boff = lds_byte(wc * 32 + fr, fq * 8);
#define PG8_AROW(pm) ((size_t)(pm) * BM + (size_t)g.a_skip * (size_t)((pm) / 32 + 1))
#define PG8_SA(b, h) (((b) * 2 + (h)) * HTB)
#define PG8_SB(b, h) ((4 + (b) * 2 + (h)) * HTB)
#define PG8_STAGE(bufoff, gbase, voff) do { _Pragma("unroll") for (int _i = 0; _i < 2; ++_i) \
        __builtin_amdgcn_global_load_lds((const unsigned*)((const char*)(gbase) + (voff)[_i]), (PG8_LAS unsigned*)(lds + (bufoff) + ldsw + _i * 8192), 16, 0, 0); } while (0)
#define PG8_LDA(dst, b, h) do { _Pragma("unroll") for (int m = 0; m < 4; ++m) _Pragma("unroll") for (int k = 0; k < 2; ++k) dst[m][k] = *(const PG8_LAS bf16x8*)(lds + PG8_SA(b, h) + aoff + m * 2048 + k * 1024); } while (0)
#define PG8_LDB(dst, b, h) do { _Pragma("unroll") for (int n = 0; n < 2; ++n) _Pragma("unroll") for (int k = 0; k < 2; ++k) dst[n][k] = *(const PG8_LAS bf16x8*)(lds + PG8_SB(b, h) + boff + n * 2048 + k * 1024); } while (0)
#define PG8_MMA(ai, bj, At, Bt) do { __builtin_amdgcn_s_setprio(1); _Pragma("unroll") for (int m = 0; m < 4; ++m) _Pragma("unroll") for (int n = 0; n < 2; ++n) _Pragma("unroll") for (int k = 0; k < 2; ++k) \
        acc[ai][bj][m][n] = __builtin_amdgcn_mfma_f32_16x16x32_bf16(Bt[n][k], At[m][k], acc[ai][bj][m][n], 0, 0, 0); __builtin_amdgcn_s_setprio(0); } while (0)
#define PG8_WAIT_V(n) asm volatile("s_waitcnt vmcnt(" #n ")" ::: "memory")
#define PG8_WAIT_L(n) asm volatile("s_waitcnt lgkmcnt(" #n ")" ::: "memory")
#define PG8_BAR __builtin_amdgcn_s_barrier()
#define PG8_SCHED __builtin_amdgcn_sched_barrier(0)
    Unit cur, nxt; int ui = 0;
    if (!S.next(0, cur)) return;
    f32x4 acc[2][2][4][2];
    if constexpr (Epi::INIT) E.init(acc, cur, wr, wc, fr, fq);
    else {
#pragma unroll
    for (int a = 0; a < 2; ++a)
#pragma unroll
        for (int b = 0; b < 2; ++b)
#pragma unroll
            for (int m = 0; m < 4; ++m)
#pragma unroll
                for (int n = 0; n < 2; ++n) acc[a][b][m][n] = (f32x4){0.f, 0.f, 0.f, 0.f};
    }
    bf16x8 At[4][2], B0[2][2], B1[2][2];
    const char* cA = (const char*)g.A + PG8_AROW(cur.pm) * rstep; const char* cB = (const char*)g.Bt + (size_t)cur.pn * tstep;
    S.a_ready(cur);
    if constexpr (SP2) {
        PG8_STAGE(PG8_SB(0, 0), cB, voffB); PG8_STAGE(PG8_SB(0, 1), cB + hstep, voffB); PG8_STAGE(PG8_SA(0, 0), cA, voffA); PG8_STAGE(PG8_SA(0, 1), cA + hstep, voffA);
        if (wr == 1) PG8_BAR;
        PG8_WAIT_V(2); PG8_BAR;
        PG8_STAGE(PG8_SB(1, 0), cB + kstep, voffB); PG8_STAGE(PG8_SA(1, 0), cA + kstep, voffA); PG8_STAGE(PG8_SB(1, 1), cB + hstep + kstep, voffB);
        PG8_WAIT_V(6); PG8_BAR;
    } else {
        PG8_STAGE(PG8_SB(0, 0), cB, voffB); PG8_STAGE(PG8_SA(0, 0), cA, voffA); PG8_STAGE(PG8_SB(0, 1), cB + hstep, voffB); PG8_STAGE(PG8_SA(0, 1), cA + hstep, voffA);
        if (wr == 1) PG8_BAR;
        PG8_WAIT_V(4); PG8_BAR;
        PG8_STAGE(PG8_SB(1, 0), cB + kstep, voffB); PG8_STAGE(PG8_SA(1, 0), cA + kstep, voffA); PG8_STAGE(PG8_SB(1, 1), cB + hstep + kstep, voffB);
        PG8_WAIT_V(6); PG8_BAR;
    }
    for (;;) {
        const bool has_next = S.next(ui + 1, nxt);
        const char* nA = has_next ? (const char*)g.A + PG8_AROW(nxt.pm) * rstep : cA; const char* nB = has_next ? (const char*)g.Bt + (size_t)nxt.pn * tstep : cB;
        for (int t = 0; t < nt; t += 2) {
            if constexpr (Epi::MID) { if (t == (nt >> 1)) E.mid(acc, cur, wr, wc, fr, fq); }
            const bool last = (t == nt - 2);
            const char* a1 = cA + (size_t)(t + 1) * kstep;
            const char* a2 = last ? nA : cA + (size_t)(t + 2) * kstep; const char* b2 = last ? nB : cB + (size_t)(t + 2) * kstep;
            const char* a3 = a2 + kstep; const char* b3 = b2 + kstep;
            if (last && has_next) S.a_ready(nxt);
            if constexpr (SP2) {
            PG8_LDB(B0, 0, 0); PG8_LDB(B1, 0, 1); PG8_SCHED; PG8_LDA(At, 0, 0); PG8_STAGE(PG8_SA(1, 1), a1 + hstep, voffA);
            PG8_WAIT_V(8); PG8_WAIT_L(0); PG8_BAR; PG8_MMA(0, 0, At, B0); PG8_MMA(0, 1, At, B1); PG8_BAR; PG8_SCHED;
            PG8_LDA(At, 0, 1); PG8_STAGE(PG8_SB(0, 0), b2, voffB); PG8_STAGE(PG8_SB(0, 1), b2 + hstep, voffB); PG8_STAGE(PG8_SA(0, 0), a2, voffA);
            PG8_WAIT_V(8); PG8_WAIT_L(0); PG8_BAR; PG8_MMA(1, 0, At, B0); PG8_MMA(1, 1, At, B1); PG8_BAR; PG8_SCHED;
            PG8_LDB(B0, 1, 0); PG8_LDB(B1, 1, 1); PG8_SCHED; PG8_LDA(At, 1, 0); PG8_STAGE(PG8_SA(0, 1), a2 + hstep, voffA);
            PG8_WAIT_V(8); PG8_WAIT_L(0); PG8_BAR; PG8_MMA(0, 0, At, B0); PG8_MMA(0, 1, At, B1); PG8_BAR; PG8_SCHED;
            PG8_LDA(At, 1, 1); PG8_STAGE(PG8_SB(1, 0), b3, voffB); PG8_STAGE(PG8_SB(1, 1), b3 + hstep, voffB); PG8_STAGE(PG8_SA(1, 0), a3, voffA);
            PG8_WAIT_V(8); PG8_WAIT_L(0); PG8_BAR; PG8_MMA(1, 0, At, B0); PG8_MMA(1, 1, At, B1); PG8_BAR; PG8_SCHED;
            } else {
            PG8_LDB(B0, 0, 0); PG8_SCHED; PG8_LDA(At, 0, 0); PG8_STAGE(PG8_SA(1, 1), a1 + hstep, voffA);
            PG8_WAIT_L(8); PG8_BAR; PG8_WAIT_L(0); PG8_MMA(0, 0, At, B0); PG8_BAR; PG8_SCHED;
            PG8_LDB(B1, 0, 1); PG8_STAGE(PG8_SB(0, 0), b2, voffB);
            PG8_BAR; PG8_WAIT_L(0); PG8_MMA(0, 1, At, B1); PG8_BAR;
            PG8_LDA(At, 0, 1); PG8_STAGE(PG8_SA(0, 0), a2, voffA);
            PG8_BAR; PG8_WAIT_L(0); PG8_MMA(1, 0, At, B0); PG8_BAR; PG8_SCHED;
            PG8_STAGE(PG8_SB(0, 1), b2 + hstep, voffB);
            PG8_WAIT_V(6); PG8_BAR; PG8_MMA(1, 1, At, B1); PG8_BAR;
            PG8_LDB(B0, 1, 0); PG8_SCHED; PG8_LDA(At, 1, 0); PG8_STAGE(PG8_SA(0, 1), a2 + hstep, voffA);
            PG8_WAIT_L(8); PG8_BAR; PG8_WAIT_L(0); PG8_MMA(0, 0, At, B0); PG8_BAR; PG8_SCHED;
            PG8_LDB(B1, 1, 1); PG8_STAGE(PG8_SB(1, 0), b3, voffB);
            PG8_BAR; PG8_WAIT_L(0); PG8_MMA(0, 1, At, B1); PG8_BAR;
            PG8_LDA(At, 1, 1); PG8_STAGE(PG8_SA(1, 0), a3, voffA);
            PG8_BAR; PG8_WAIT_L(0); PG8_MMA(1, 0, At, B0); PG8_BAR; PG8_SCHED;
            PG8_STAGE(PG8_SB(1, 1), b3 + hstep, voffB);
            PG8_WAIT_V(6); PG8_BAR; PG8_MMA(1, 1, At, B1); PG8_BAR;
            }
        }
        if constexpr (ALIGN_EPI) { if (wr == 0) PG8_BAR; }
        E(acc, cur, wr, wc, fr, fq); S.done(cur);
        if (!has_next) break;
        if constexpr (Epi::INIT) E.init(acc, nxt, wr, wc, fr, fq);
        else {
#pragma unroll
        for (int a = 0; a < 2; ++a)
#pragma unroll
            for (int b = 0; b < 2; ++b)
#pragma unroll
                for (int m = 0; m < 4; ++m)
#pragma unroll
                    for (int n = 0; n < 2; ++n) acc[a][b][m][n] = (f32x4){0.f, 0.f, 0.f, 0.f};
        }
        cur = nxt; cA = nA; cB = nB; ++ui;
        if constexpr (ALIGN_EPI) { if (wr == 1) PG8_BAR; }
    }
    PG8_WAIT_V(0);
    if constexpr (!ALIGN_EPI) { if (wr == 0) PG8_BAR; }
    PG8_BAR;
#undef PG8_AROW
#undef PG8_SA
#undef PG8_SB
#undef PG8_STAGE
#undef PG8_LDA
#undef PG8_LDB
#undef PG8_MMA
#undef PG8_WAIT_V
#undef PG8_WAIT_L
#undef PG8_BAR
#undef PG8_SCHED
}
}

#ifndef PG8_SP2
#define PG8_SP2 true
#endif
#ifndef PG8_ALIGN
#define PG8_ALIGN true
#endif

namespace att {
typedef unsigned short bf16_t;
typedef short bf16x8 __attribute__((ext_vector_type(8)));
typedef short s16x4 __attribute__((ext_vector_type(4)));
typedef float f32x16 __attribute__((ext_vector_type(16)));
typedef float f32x4 __attribute__((ext_vector_type(4)));
typedef unsigned u32x4 __attribute__((ext_vector_type(4)));
typedef float f32x2_t __attribute__((ext_vector_type(2))); typedef __bf16 bf16x2_t __attribute__((ext_vector_type(2)));
typedef __attribute__((address_space(3))) unsigned char lds_u8;
typedef __attribute__((address_space(3))) const float lds_cf32;
typedef short v4i16_t __attribute__((ext_vector_type(4)));
__device__ __forceinline__ unsigned cvtpk(float lo, float hi) { f32x2_t v = {lo, hi}; bf16x2_t b = __builtin_convertvector(v, bf16x2_t); return __builtin_bit_cast(unsigned, b); }
__device__ __forceinline__ float bf_lo(unsigned w) { return __uint_as_float(w << 16); }
__device__ __forceinline__ float bf_hi(unsigned w) { return __uint_as_float(w & 0xffff0000u); }
__device__ __forceinline__ s16x4 vtr(const lds_u8* p) { return __builtin_bit_cast(s16x4, __builtin_amdgcn_ds_read_tr16_b64_v4i16((__attribute__((address_space(3))) v4i16_t*)p)); }

constexpr int WAVE_LDS = 16384;
constexpr int OST_PITCH = 272;

struct Tensors {
    const bf16_t *QA, *KA, *VA, *QB, *KB, *VB, *SZ; bf16_t* BR; const float* sinks;
};
struct LaneK {
    int lane, c, hi;
    unsigned kw[4], vw[4];
    unsigned kr[4];
    unsigned vr[2];
    __device__ __forceinline__ void init(int lane_) {
        lane = lane_; c = lane & 31; hi = lane >> 5;
#pragma unroll
        for (int i = 0; i < 4; ++i) {
            const int row = 8 * i + (lane >> 3), ch = lane & 7;
            kw[i] = (unsigned)(row * 128 + ((ch ^ ((row >> 1) & 7)) << 4));
            vw[i] = (unsigned)(row * 128 + ((ch ^ (((row >> 1) & 1) << 2)) << 4));
        }
#pragma unroll
        for (int s = 0; s < 4; ++s) kr[s] = (unsigned)(c * 128 + ((((2 * s + hi)) ^ ((c >> 1) & 7)) << 4));
        const int cg = (lane >> 4) & 1, q = (lane & 15) >> 2, p = lane & 3, qb = (q >> 1) & 1;
#pragma unroll
        for (int dh = 0; dh < 2; ++dh) vr[dh] = (unsigned)((4 * hi + q) * 128 + ((4 * (dh ^ qb) + 2 * cg + (p >> 1)) << 4) + (p & 1) * 8);
    }
};

__device__ __forceinline__ void pack_p(const f32x16& w, bf16x8& p0, bf16x8& p1) {
    u32x4 a, b;
    a.x = cvtpk(w[0], w[1]); a.y = cvtpk(w[2], w[3]); a.z = cvtpk(w[4], w[5]); a.w = cvtpk(w[6], w[7]);
    b.x = cvtpk(w[8], w[9]); b.y = cvtpk(w[10], w[11]); b.z = cvtpk(w[12], w[13]); b.w = cvtpk(w[14], w[15]);
    p0 = __builtin_bit_cast(bf16x8, a); p1 = __builtin_bit_cast(bf16x8, b);
}
__device__ __forceinline__ void load_tile(u32x4 (&r)[4], const bf16_t* p) {
#pragma unroll
    for (int i = 0; i < 4; ++i) r[i] = *(const u32x4*)(p + i * 512);
}
__device__ __forceinline__ void put_tile(lds_u8* buf, const unsigned (&off)[4], const u32x4 (&r)[4]) {
#pragma unroll
    for (int i = 0; i < 4; ++i) *(__attribute__((address_space(3))) u32x4*)(buf + off[i]) = r[i];
}
__device__ __forceinline__ f32x16 qk_tile(const lds_u8* kbuf, const LaneK& L, const bf16x8 (&qf)[4]) {
    f32x16 S = {};
#pragma unroll
    for (int s = 0; s < 4; ++s) {
        const bf16x8 kf = *(const __attribute__((address_space(3))) bf16x8*)(kbuf + L.kr[s]);
        S = __builtin_amdgcn_mfma_f32_32x32x16_bf16(kf, qf[s], S, 0, 0, 0);
    }
    return S;
}
__device__ __forceinline__ void pv_tile(const lds_u8* vbuf, const LaneK& L, const f32x16& w, f32x16& o0, f32x16& o1) {
    bf16x8 pb[2]; pack_p(w, pb[0], pb[1]);
#pragma unroll
    for (int dh = 0; dh < 2; ++dh)
#pragma unroll
        for (int s = 0; s < 2; ++s) {
            const s16x4 lo = vtr(vbuf + L.vr[dh] + (16 * s) * 128), hi4 = vtr(vbuf + L.vr[dh] + (16 * s + 8) * 128);
            const bf16x8 vf = (bf16x8){lo[0], lo[1], lo[2], lo[3], hi4[0], hi4[1], hi4[2], hi4[3]};
            if (dh == 0) o0 = __builtin_amdgcn_mfma_f32_32x32x16_bf16(vf, pb[s], o0, 0, 0, 0);
            else         o1 = __builtin_amdgcn_mfma_f32_32x32x16_bf16(vf, pb[s], o1, 0, 0, 0);
        }
}
__device__ __forceinline__ void write_out(lds_u8* st, const LaneK& L, const f32x16& o0, const f32x16& o1, float scale, const u32x4 (&sz)[4], bf16_t* brp) {
#pragma unroll
    for (int dh = 0; dh < 2; ++dh)
#pragma unroll
        for (int g = 0; g < 4; ++g) {
            const f32x16& o = dh ? o1 : o0;
            const f32x4 v = {o[4 * g] * scale, o[4 * g + 1] * scale, o[4 * g + 2] * scale, o[4 * g + 3] * scale};
            *(__attribute__((address_space(3))) f32x4*)(st + L.c * OST_PITCH + (32 * dh + 8 * g + 4 * L.hi) * 4) = v;
        }
#pragma unroll
    for (int i = 0; i < 4; ++i) {
        const int row = 8 * i + (L.lane >> 3), ch = L.lane & 7;
        const f32x4 a = *(const __attribute__((address_space(3))) f32x4*)(st + row * OST_PITCH + ch * 32);
        const f32x4 b = *(const __attribute__((address_space(3))) f32x4*)(st + row * OST_PITCH + ch * 32 + 16);
        u32x4 w;
        w.x = cvtpk(a[0] * bf_lo(sz[i].x), a[1] * bf_hi(sz[i].x)); w.y = cvtpk(a[2] * bf_lo(sz[i].y), a[3] * bf_hi(sz[i].y));
        w.z = cvtpk(b[0] * bf_lo(sz[i].z), b[1] * bf_hi(sz[i].z)); w.w = cvtpk(b[2] * bf_lo(sz[i].w), b[3] * bf_hi(sz[i].w));
        *(u32x4*)(brp + (size_t)row * 1024 + ch * 8) = w;
    }
}

#define SB_TILE(KR, VR) do { \
        lds_u8* kbuf = wb + cur * 8192; lds_u8* vbuf = kbuf + 4096; \
        put_tile(kbuf, L.kw, KR); put_tile(vbuf, L.vw, VR); \
        if (tile > 4) { load_tile(KR, Kt + (size_t)(tile - 2) * 2048); load_tile(VR, Vt + (size_t)(tile - 2) * 2048); } \
        const f32x16 S = qk_tile(kbuf, L, qf); \
          \
        f32x16 beta, om; \
        const int kb = 32 * tile + 4 * hi; \
        if (tile == t0 || tile == 3) { \
            _Pragma("unroll") for (int r = 0; r < 16; ++r) { \
                const int kv = kb + (r & 3) + 8 * (r >> 2); \
                const bool vis = (kv < qpos) && (kv >= 112); \
                float e = __builtin_amdgcn_exp2f(fminf(S[r], 80.f)); \
                e = vis ? e : 0.f; \
                const float rr = __builtin_amdgcn_rcpf(1.0f + e); \
                beta[r] = e * rr; om[r] = rr; \
            } \
        } else { \
            _Pragma("unroll") for (int r = 0; r < 16; ++r) { \
                const float e = __builtin_amdgcn_exp2f(fminf(S[r], 80.f)); \
                const float rr = __builtin_amdgcn_rcpf(1.0f + e); \
                beta[r] = e * rr; om[r] = rr; \
            } \
        } \
          \
        float sfx[16], Tt[4], To[4]; \
        _Pragma("unroll") for (int g = 0; g < 4; ++g) { \
            sfx[4 * g + 3] = 1.f; sfx[4 * g + 2] = om[4 * g + 3]; sfx[4 * g + 1] = sfx[4 * g + 2] * om[4 * g + 2]; sfx[4 * g] = sfx[4 * g + 1] * om[4 * g + 1]; \
            Tt[g] = sfx[4 * g] * om[4 * g]; \
        } \
        _Pragma("unroll") for (int g = 0; g < 4; ++g) To[g] = __shfl_xor(Tt[g], 32); \
        float pref = carry; \
        f32x16 w; \
        _Pragma("unroll") for (int g = 3; g >= 0; --g) { \
            const float T0 = hi ? To[g] : Tt[g], T1 = hi ? Tt[g] : To[g]; \
            const float P1 = pref, P0 = P1 * T1, Pg = hi ? P1 : P0; \
            _Pragma("unroll") for (int j = 0; j < 4; ++j) w[4 * g + j] = beta[4 * g + j] * (Pg * sfx[4 * g + j]); \
            pref = P0 * T0; \
        } \
        carry = pref; \
        pv_tile(vbuf, L, w, o0, o1); \
        stop = (tile <= 3) || !__any(carry >= SB_EPS); \
        --tile; cur ^= 1; \
    } while (0)
__device__ __forceinline__ void item_sb(const Tensors& T, lds_u8* wb, const LaneK& L, int b, int h, int qt) {
    const int c = L.c, hi = L.hi, lane = L.lane;
    const int p0 = 128 + 32 * qt;
    const size_t headrow = (size_t)(b * 8 + h) * LP;
    const bf16_t* Qp = T.QA + (headrow + p0 + c) * 64 + 8 * hi;
    bf16x8 qf[4];
#pragma unroll
    for (int s = 0; s < 4; ++s) qf[s] = *(const bf16x8*)(Qp + 16 * s);
    const bf16_t* Kt = T.KA + headrow * 64 + lane * 8;
    const bf16_t* Vt = T.VA + headrow * 64 + lane * 8;
    const int t0 = p0 >> 5; int tile = t0, cur = 0;
    u32x4 kA[4], vA[4], kB[4], vB[4];
    load_tile(kA, Kt + (size_t)tile * 2048); load_tile(vA, Vt + (size_t)tile * 2048);
    load_tile(kB, Kt + (size_t)(tile - 1) * 2048); load_tile(vB, Vt + (size_t)(tile - 1) * 2048);
    u32x4 sz[4];
    load_tile(sz, T.SZ + ((size_t)(b * 16 + h) * LP + p0) * 64 + lane * 8);
    f32x16 o0 = {}, o1 = {};
    float carry = 1.f;
    const int qpos = p0 + c;
    bool stop = false;
    for (;;) {
        SB_TILE(kA, vA); if (stop) break;
        SB_TILE(kB, vB); if (stop) break;
    }
    write_out(wb, L, o0, o1, 1.f, sz, T.BR + ((size_t)b * SEQ + 32 * qt) * 1024 + h * 64);
}
#undef SB_TILE

__device__ __forceinline__ void item_sw(const Tensors& T, lds_u8* wb, lds_cf32* btl, const LaneK& L, int b, int hq, int qt) {
    const int c = L.c, hi = L.hi, lane = L.lane, kvh = hq >> 2;
    const int p0 = 128 + 32 * qt, kt = p0 >> 5;
    const bf16_t* Qp = T.QB + ((size_t)(b * 8 + hq) * LP + p0 + c) * 64 + 8 * hi;
    bf16x8 qf[4];
#pragma unroll
    for (int s = 0; s < 4; ++s) qf[s] = *(const bf16x8*)(Qp + 16 * s);
    const bf16_t* Kt = T.KB + ((size_t)(b * 2 + kvh) * LP + (size_t)(kt - 4) * 32) * 64 + lane * 8;
    const bf16_t* Vt = T.VB + ((size_t)(b * 2 + kvh) * LP + (size_t)(kt - 4) * 32) * 64 + lane * 8;
    u32x4 reg[3][4];
    load_tile(reg[0], Kt); load_tile(reg[1], Kt + 2048); load_tile(reg[2], Kt + 2 * 2048);
    u32x4 sz[4];
    load_tile(sz, T.SZ + ((size_t)(b * 16 + 8 + hq) * LP + p0) * 64 + lane * 8);
    f32x16 S[5];
#pragma unroll
    for (int ti = 0; ti < 5; ++ti) {
        lds_u8* kbuf = wb + (ti & 1) * 8192;
        put_tile(kbuf, L.kw, reg[ti % 3]);
        const int nx = ti + 3;
        if (nx < 5) load_tile(reg[ti % 3], Kt + (size_t)nx * 2048); else load_tile(reg[ti % 3], Vt + (size_t)(nx - 5) * 2048);
        S[ti] = qk_tile(kbuf, L, qf);
    }
    const float sink2 = T.sinks[hq] * LOG2E;
    lds_cf32* bt = btl + hq * BT_LD + 32 + (c - 4 * hi);
    float mx = sink2;
    const bool lead = kt < 8;
#pragma unroll
    for (int ti = 0; ti < 5; ++ti)
#pragma unroll
        for (int r = 0; r < 16; ++r) {
            const int ko = (r & 3) + 8 * (r >> 2);
            const int relc = 128 - 32 * ti - ko;
            const int rel = relc + c - 4 * hi;
            float l = S[ti][r] + bt[relc];
            if (ti == 0) l = (rel < 128) ? l : -INFINITY;
            if (ti == 4) l = (rel >= 0) ? l : -INFINITY;
            if (lead) { const int kv = 32 * (kt - 4 + ti) + ko + 4 * hi; l = (kv >= 112) ? l : -INFINITY; }
            S[ti][r] = l; mx = fmaxf(mx, l);
        }
    mx = fmaxf(mx, __shfl_xor(mx, 32));
    float sum = 0.f;
#pragma unroll
    for (int ti = 0; ti < 5; ++ti)
#pragma unroll
        for (int r = 0; r < 16; ++r) { const float pv = __builtin_amdgcn_exp2f(S[ti][r] - mx); S[ti][r] = pv; sum += pv; }
    sum += __shfl_xor(sum, 32);
    const float denom = sum + __builtin_amdgcn_exp2f(sink2 - mx);
    f32x16 o0 = {}, o1 = {};
#pragma unroll
    for (int ti = 0; ti < 5; ++ti) {
        lds_u8* vbuf = wb + ((ti + 1) & 1) * 8192 + 4096;
        put_tile(vbuf, L.vw, reg[(ti + 5) % 3]);
        if (ti + 3 < 5) load_tile(reg[(ti + 5) % 3], Vt + (size_t)(ti + 3) * 2048);
        pv_tile(vbuf, L, S[ti], o0, o1);
    }
    write_out(wb, L, o0, o1, 1.0f / denom, sz, T.BR + ((size_t)b * SEQ + 32 * qt) * 1024 + 512 + hq * 64);
}

__device__ __forceinline__ void attn_phase(const Tensors& T, lds_u8* wb, lds_cf32* btl, int bi0, int bi1, int wave, int lane) {
    LaneK L; L.init(lane);
    for (int bi = bi0; bi < bi1; ++bi) {
        const int kind = bi & 1, r = bi >> 1, qt = (r & 31) * 8 + wave, h = (r >> 5) & 7, b = r >> 8;
        if (kind == 0) item_sb(T, wb, L, b, h, qt); else item_sw(T, wb, btl, L, b, h, qt);
    }
}
}

constexpr int NWAVES = 8;
constexpr int N_LAUNCHES = MK_N_LAUNCHES;
constexpr int PER_PHASE = 5;
constexpr int N_BAR_REGIONS = (MK_N_LAUNCHES == PER_PHASE) ? 1 : MK_N_LAUNCHES;

constexpr size_t MiB = 1u << 20;
constexpr size_t WS_CTL = 0, CTL_ZERO_BYTES = 64 * 1024;
constexpr size_t WS_BT1 = 1 * MiB;
constexpr size_t WS_BT3 = 12 * MiB;
constexpr size_t WS_BT4 = 14 * MiB;
constexpr size_t WS_RS = 16 * MiB;
constexpr size_t WS_BTAB = WS_RS + 128 * 1024;
constexpr size_t WS_XB = 17 * MiB;
constexpr size_t WS_QA = 50 * MiB;
constexpr size_t WS_KA = 67 * MiB;
constexpr size_t WS_VTA = 84 * MiB;
constexpr size_t WS_QB = 101 * MiB;
constexpr size_t WS_SZ = 118 * MiB;
constexpr size_t WS_MG = WS_SZ;
constexpr size_t WS_KB = 151 * MiB;
constexpr size_t WS_VTB = 156 * MiB;
constexpr size_t WS_BR = 161 * MiB;
constexpr size_t WS_END = 193 * MiB;
static_assert(WS_BT1 + (size_t)NPROJ * DM * 2 <= WS_BT3 && WS_XB + (size_t)MP * DM * 2 <= WS_QA && WS_QA + (size_t)MP * 512 * 2 <= WS_KA && WS_VTA + (size_t)MP * 512 * 2 <= WS_QB &&
              WS_QB + (size_t)MP * 512 * 2 <= WS_SZ && WS_SZ + (size_t)MP * DM * 2 <= WS_KB && WS_KB + (size_t)MP * 128 * 2 <= WS_VTB &&
              WS_VTB + (size_t)MP * 128 * 2 <= WS_BR && WS_BR + (size_t)MR * DM * 2 <= WS_END, "d_ws map");
constexpr int CW_TMO = 0, CW_CODE = 1;
constexpr int CW_BAR = 4096;

constexpr int RING_OFF = 0, RING_BYTES = 131072;
constexpr int LDSCTL_OFF = RING_BYTES, MISC_OFF = LDSCTL_OFF + 320;
constexpr int BTL_OFF = RING_BYTES + 1024;
constexpr int LDS_BYTES = 147456;
static_assert(MISC_OFF + 128 <= BTL_OFF && BTL_OFF + 8 * BT_LD * 4 <= LDS_BYTES, "LDS map");

#define GAS __attribute__((address_space(1)))
#define LAS __attribute__((address_space(3)))
typedef unsigned short bf16;
typedef unsigned v4u __attribute__((ext_vector_type(4)));
typedef float f32x4 __attribute__((ext_vector_type(4)));
typedef GAS unsigned gu32;
#define RLX_AGENT __ATOMIC_RELAXED, __HIP_MEMORY_SCOPE_AGENT
#define LDS_WAIT() asm volatile("s_waitcnt lgkmcnt(0)" ::: "memory")
#define VM_WAIT() asm volatile("s_waitcnt vmcnt(0)" ::: "memory")
__device__ __forceinline__ unsigned f2bf(float f) { unsigned u = __builtin_bit_cast(unsigned, f); return (u + 0x7fffu + ((u >> 16) & 1u)) >> 16; }
__device__ __forceinline__ unsigned pk2(float lo, float hi) { return f2bf(lo) | (f2bf(hi) << 16); }

#define XB_TMO      128
#define XB_XCNT(j)  (256  + 64 * (j))
#define XB_XSUB(j)  (1280 + 64 * (j))
#define XB_XGEN(j)  (2304 + 64 * (j))
#define XB_TOP      3328
#define XB_TOPGEN   3392
#define XCD_BAR_WORDS 3456
#define XB_SPIN_CAP (1u << 18)

__device__ __forceinline__ unsigned xb_ld(unsigned* p)              { return __hip_atomic_load(p, __ATOMIC_RELAXED, __HIP_MEMORY_SCOPE_AGENT); }
__device__ __forceinline__ unsigned xb_add(unsigned* p, unsigned v) { return __hip_atomic_fetch_add(p, v, __ATOMIC_RELAXED, __HIP_MEMORY_SCOPE_AGENT); }
__device__ __forceinline__ unsigned xb_xcc_id() { return (unsigned)__builtin_amdgcn_s_getreg((3 << 11) | 20) & 0xFu; }
#define XB_SPIN(cond, bar) do { unsigned _sp = 0; while (cond) { __builtin_amdgcn_s_sleep(1); \
    if ((++_sp & 255u) == 0u) { if (xb_ld(&(bar)[XB_TMO])) break; if (_sp > XB_SPIN_CAP) { atomicAdd(&(bar)[XB_TMO], 1u); break; } } } } while (0)

struct XcdBarrier { unsigned* bar; unsigned x; volatile LAS unsigned* st; };

__device__ __forceinline__ XcdBarrier xcd_barrier_post(unsigned* bar, volatile LAS unsigned* st) {
    XcdBarrier b; b.bar = bar; b.x = xb_xcc_id(); b.st = st;
    if (threadIdx.x == 0) (void)xb_add(&bar[XB_XCNT(b.x)], 1u);
    return b;
}
__device__ __forceinline__ void xcd_barrier_complete(unsigned* bar, unsigned x, unsigned& nloc, unsigned& nx) {
    const unsigned G = gridDim.x * gridDim.y * gridDim.z;
    unsigned sum, cnt, mine, sp = 0u;
    for (;;) {
        sum = 0u; cnt = 0u; mine = 0u;
#pragma unroll
        for (unsigned j = 0; j < 16; ++j) { const unsigned c = xb_ld(&bar[XB_XCNT(j)]); sum += c; cnt += (c > 0u) ? 1u : 0u; mine = (j == x) ? c : mine; }
        if (sum == G) break;
        __builtin_amdgcn_s_sleep(1);
        if ((++sp & 255u) == 0u) { if (xb_ld(&bar[XB_TMO])) break; if (sp > XB_SPIN_CAP) { atomicAdd(&bar[XB_TMO], 1u); break; } }
    }
    nloc = mine > 0u ? mine : 1u; nx = cnt > 0u ? cnt : 1u;
}
__device__ __forceinline__ void xcd_barrier(const XcdBarrier& b) {
    asm volatile("s_waitcnt vmcnt(0)" ::: "memory");
    __syncthreads();
    if (threadIdx.x == 0) {
        unsigned* bar = b.bar;
        __builtin_amdgcn_s_waitcnt(0);
        unsigned nloc = b.st[0], nx = b.st[1];
        if (nloc == 0u) { xcd_barrier_complete(bar, b.x, nloc, nx); b.st[0] = nloc; b.st[1] = nx; }
        const unsigned old = xb_add(&bar[XB_XSUB(b.x)], 1u);
        const unsigned gen = old / nloc;
        if (old + 1u == (gen + 1u) * nloc) {
            __builtin_amdgcn_fence(__ATOMIC_RELEASE, "agent");
            asm volatile("s_waitcnt vmcnt(0)" ::: "memory");
            const unsigned og = xb_add(&bar[XB_TOP], 1u);
            const unsigned tg = og / nx;
            if (og + 1u == (tg + 1u) * nx) xb_add(&bar[XB_TOPGEN], 1u);
            else XB_SPIN(xb_ld(&bar[XB_TOPGEN]) == tg, bar);
            __builtin_amdgcn_fence(__ATOMIC_ACQUIRE, "agent");
            xb_add(&bar[XB_XGEN(b.x)], 1u);
            asm volatile("s_waitcnt vmcnt(0)" ::: "memory");
        } else {
            XB_SPIN(xb_ld(&bar[XB_XGEN(b.x)]) == gen, bar);
            __builtin_amdgcn_fence(__ATOMIC_ACQUIRE, "agent");
            asm volatile("s_waitcnt vmcnt(0)" ::: "memory");
        }
    }
    __syncthreads();
}

__device__ __forceinline__ float wave_sum(float v) {
#pragma unroll
    for (int o = 1; o < 64; o <<= 1) v += __shfl_xor(v, o);
    return v;
}
__device__ __forceinline__ void p0_transpose_item(const float* W, const float* kscale, int K, int N, bf16* WT, int ldk, int koff, LAS float* scr, int item, int lane, int gate_n0 = -1) {
    const int nblk = N / 32, kb = item / nblk, nb = item % nblk, k0 = 64 * kb, n0 = 32 * nb;
    const int r8 = lane >> 3, c4 = (lane & 7) * 4;
    f32x4 w[8]; float ks[8];
#pragma unroll
    for (int i = 0; i < 8; ++i) { w[i] = *(const GAS f32x4*)(W + (size_t)(k0 + r8 + 8 * i) * N + n0 + c4); ks[i] = kscale ? kscale[k0 + r8 + 8 * i] : 1.0f; }
#pragma unroll
    for (int i = 0; i < 8; ++i) { LAS float* d = scr + (r8 + 8 * i) * 33 + c4; d[0] = w[i].x * ks[i]; d[1] = w[i].y * ks[i]; d[2] = w[i].z * ks[i]; d[3] = w[i].w * ks[i]; }
    LDS_WAIT(); asm volatile("" ::: "memory");
    const int c = lane & 7;
    const int srow0 = (n0 & ~255) + 128 * ((n0 >> 5) & 1) + 32 * ((n0 >> 6) & 3);
#pragma unroll
    for (int j = 0; j < 4; ++j) { const int n = (lane >> 3) + 8 * j; const LAS float* s = scr + (8 * c) * 33 + n;
        v4u o; o.x = pk2(s[0 * 33], s[1 * 33]); o.y = pk2(s[2 * 33], s[3 * 33]); o.z = pk2(s[4 * 33], s[5 * 33]); o.w = pk2(s[6 * 33], s[7 * 33]);
        *(GAS v4u*)(WT + (size_t)(srow0 + n) * ldk + koff + k0 + 8 * c) = o; }
    LDS_WAIT(); asm volatile("" ::: "memory");
}

struct Args { const float* in[10]; float* out; unsigned char* ws; int ph_lo, ph_hi, li, pad; };
__global__ void __launch_bounds__(NWAVES * 64, 2) mk_fwd(Args args) {
    extern __shared__ __attribute__((aligned(16))) unsigned char lds[];
    LAS unsigned char* const L = (LAS unsigned char*)lds;
    volatile LAS unsigned* const MISC = (volatile LAS unsigned*)(L + MISC_OFF);
    const int tid = threadIdx.x, lane = tid & 63, wave = __builtin_amdgcn_readfirstlane(tid >> 6);
    const int G = gridDim.x; const int bx = blockIdx.x; const int vcu = (G % 8 == 0) ? (bx % 8) * (G / 8) + bx / 8 : bx;
    typedef __attribute__((address_space(4))) const Args CArgs;
    CArgs* ap = (CArgs*)__builtin_amdgcn_kernarg_segment_ptr();
#define PTRS \
    asm volatile("" : "+s"(ap)); \
    unsigned char* const ws = ap->ws; gu32* const ctl = (gu32*)(ws + WS_CTL); (void)ctl; \
    const float* const x = ap->in[0]; const float* const meta = ap->in[1]; const float* const rel_bias = ap->in[2]; const float* const norm_w = ap->in[3]; const float* const w_in = ap->in[4]; \
    const float* const q_gain = ap->in[5]; const float* const k_gain = ap->in[6]; const float* const sinks = ap->in[7]; const float* const w_branch = ap->in[8]; const float* const w_out = ap->in[9]; \
    bf16* const BT1 = (bf16*)(ws + WS_BT1); bf16* const BT3 = (bf16*)(ws + WS_BT3); bf16* const BT4 = (bf16*)(ws + WS_BT4); \
    float* const RS = (float*)(ws + WS_RS); float* const BTAB = (float*)(ws + WS_BTAB); \
    bf16* const XB = (bf16*)(ws + WS_XB); bf16* const QA = (bf16*)(ws + WS_QA); bf16* const KA = (bf16*)(ws + WS_KA); bf16* const VTA = (bf16*)(ws + WS_VTA); bf16* const QB = (bf16*)(ws + WS_QB); \
    bf16* const GS = (bf16*)ap->out; bf16* const SZ = (bf16*)(ws + WS_SZ); bf16* const MG = (bf16*)(ws + WS_MG); bf16* const KB = (bf16*)(ws + WS_KB); bf16* const VTB = (bf16*)(ws + WS_VTB); bf16* const BR = (bf16*)(ws + WS_BR); \
    (void)x; (void)meta; (void)rel_bias; (void)norm_w; (void)w_in; (void)q_gain; (void)k_gain; (void)sinks; (void)w_branch; (void)w_out; (void)BT1; (void)BT3; (void)BT4; (void)RS; (void)BTAB; \
    (void)XB; (void)QA; (void)KA; (void)VTA; (void)QB; (void)GS; (void)SZ; (void)MG; (void)KB; (void)VTB; (void)BR;
    gu32* ctl0; { PTRS; ctl0 = ctl; }
    for (int u = tid; u < (LDS_BYTES - LDSCTL_OFF) / 4; u += NWAVES * 64) ((LAS unsigned*)(L + LDSCTL_OFF))[u] = 0u;
    __syncthreads();
    const int bli = (N_LAUNCHES == PER_PHASE) ? 0 : ap->li;
    XcdBarrier bar; bar.bar = (unsigned*)(ctl0 + CW_BAR) + bli * XCD_BAR_WORDS; bar.x = 0; bar.st = nullptr;
    if (N_LAUNCHES != PER_PHASE) bar = xcd_barrier_post((unsigned*)(ctl0 + CW_BAR) + bli * XCD_BAR_WORDS, MISC + 8);
#define GRID_BAR(seam) do { if (N_LAUNCHES == PER_PHASE) { if (tid == 0) __hip_atomic_store(ctl0 + CW_TMO, 0xBADBA0u | (unsigned)(seam), RLX_AGENT); } else { xcd_barrier(bar); } } while (0)
    const int lo = ap->ph_lo, hi = ap->ph_hi;
#define IN(k) (lo <= (k) && (k) < hi)
#define BOTH(k) (IN(k) && IN((k) + 1))
    const int gw = vcu * NWAVES + wave, NGW = G * NWAVES;

    if (IN(0)) {
        PTRS
        LAS float* scr = (LAS float*)(L + RING_OFF + wave * 16384);
        constexpr int I_IN = (DM / 64) * (NPROJ / 32), I_BR = (512 / 64) * (DM / 32), I_OUT = (DM / 64) * (DM / 32);
        constexpr int NITEMS = I_IN + 2 * I_BR + I_OUT;
        for (int it = gw; it < NITEMS; it += NGW) {
            int r = it;
            if (r < I_IN) { p0_transpose_item(w_in, norm_w, DM, NPROJ, BT1, DM, 0, scr, r, lane, NPROJ1); continue; } r -= I_IN;
            if (r < I_BR) { p0_transpose_item(w_branch, nullptr, 512, DM, BT3, DM, 0, scr, r, lane); continue; } r -= I_BR;
            if (r < I_BR) { p0_transpose_item(w_branch + (size_t)512 * DM, nullptr, 512, DM, BT3, DM, 512, scr, r, lane); continue; } r -= I_BR;
            p0_transpose_item(w_out, nullptr, DM, DM, BT4, DM, 0, scr, r, lane);
        }
        for (int m0 = gw; m0 < MP; m0 += 4 * NGW) {
            f32x4 v[4][4]; float keep[4];
#pragma unroll
            for (int r = 0; r < 4; ++r) {
                const int m = m0 + r * NGW, mm = m < MP ? m : 0;
                const int b = mm >= LP ? 1 : 0, pos = mm - b * LP;
                const bool real = (m < MP) && (pos >= 112);
                const float* src = !real ? x : (pos < 128 ? meta + (size_t)(pos - 112) * DM : x + ((size_t)b * SEQ + (pos - 128)) * DM);
                keep[r] = real ? 1.f : 0.f;
                const GAS f32x4* xr = (const GAS f32x4*)src + lane;
#pragma unroll
                for (int j = 0; j < 4; ++j) v[r][j] = __builtin_nontemporal_load(xr + 64 * j);
            }
#pragma unroll
            for (int r = 0; r < 4; ++r) {
                const int m = m0 + r * NGW;
                float s = 0.f;
#pragma unroll
                for (int j = 0; j < 4; ++j) { if (keep[r] == 0.f) v[r][j] = (f32x4){0.f, 0.f, 0.f, 0.f}; s += (v[r][j].x * v[r][j].x + v[r][j].y * v[r][j].y) + (v[r][j].z * v[r][j].z + v[r][j].w * v[r][j].w); }
                s = wave_sum(s);
                if (m < MP) {
                    const float rs = 1.0f / sqrtf(s * (1.0f / DM) + RMS_EPS);
                    GAS unsigned long long* o8 = (GAS unsigned long long*)(XB + (size_t)m * DM) + lane;
#pragma unroll
                    for (int j = 0; j < 4; ++j) o8[64 * j] = (unsigned long long)pk2(v[r][j].x * rs, v[r][j].y * rs) | ((unsigned long long)pk2(v[r][j].z * rs, v[r][j].w * rs) << 32);
                }
            }
        }
        if (bx == 0) {
            for (int i = tid; i < 8 * BT_LD; i += NWAVES * 64) {
                const int h = i / BT_LD, rel = i % BT_LD - 32;
                float v = 0.f;
                if (rel >= 0 && rel < 128) {
                    int bucket = rel;
                    if (rel >= 16) { int l = 16 + (int)(log2f((float)rel * (1.0f / 16.0f)) * (16.0f / 3.0f)); bucket = l < 31 ? l : 31; }
                    v = rel_bias[bucket * 8 + h] * LOG2E;
                }
                BTAB[i] = v;
            }
        }
        if (BOTH(0)) GRID_BAR(0);
    }

    constexpr int NUNITS = (MP / 256) * (NPROJ / 256), NU0 = (MP / 256) * (NPROJ1 / 256);
    const int F1 = (5 * G >= NU0 && 5 * G <= NUNITS) ? 5 * G : NUNITS;
    if (IN(1)) {
        PTRS
        pg8::Gemm g{XB, BT1, MP, NPROJ, DM, 0}; const pg8::ListOrder S{MP / 256, NPROJ1 / 256, NGATE / 256, G, bx, 0, F1};
        pg8::EpiProj E{QA, KA, VTA, SZ, QB, KB, VTB, GS, q_gain, k_gain};
        pg8::gemm_phase<pg8::EpiProj, pg8::ListOrder, PG8_ALIGN, PG8_SP2>(L + RING_OFF, g, S, E, wave);
        if (BOTH(1)) GRID_BAR(1);
    }

    if (IN(2)) {
        PTRS
        const int tail = NUNITS - F1;
        int bi0, bi1;
        if (G == 256 && tail > 0) { const int n2 = tail % G; if (bx < n2) { bi0 = 2 * bx; bi1 = bi0 + 2; } else { bi0 = 2 * n2 + 5 * (bx - n2); bi1 = bi0 + 5; } }
        else { const int per = (1024 + G - 1) / G; bi0 = bx * per; bi1 = bi0 + per; }
        bi0 = bi0 < 1024 ? bi0 : 1024; bi1 = bi1 < 1024 ? bi1 : 1024;
        {
            LAS float* btl = (LAS float*)(L + BTL_OFF);
            for (int i = tid; i < 8 * BT_LD; i += NWAVES * 64) btl[i] = BTAB[i];
            __syncthreads();
            const att::Tensors T{QA, KA, VTA, QB, KB, VTB, SZ, BR, sinks};
            att::attn_phase(T, L + RING_OFF + wave * att::WAVE_LDS, (att::lds_cf32*)btl, bi0, bi1, wave, lane);
            __syncthreads();
        }
        {
            pg8::Gemm g{XB, BT1, MP, NPROJ, DM, 0}; const pg8::ListOrder S{MP / 256, NPROJ1 / 256, NGATE / 256, G, bx, F1, NUNITS};
            pg8::EpiProj E{QA, KA, VTA, SZ, QB, KB, VTB, GS, q_gain, k_gain};
            pg8::gemm_phase<pg8::EpiProj, pg8::ListOrder, PG8_ALIGN, PG8_SP2>(L + RING_OFF, g, S, E, wave);
        }
        if (BOTH(2)) GRID_BAR(2);
    }

    if (IN(3)) {
        PTRS
        pg8::Gemm g{BR, BT3, MR, DM, DM, 0}; pg8::StaticOrder S; S.init(MR, DM, G, bx);
        pg8::EpiMerge E{GS, MG};
        pg8::gemm_phase<pg8::EpiMerge, pg8::StaticOrder, PG8_ALIGN, PG8_SP2>(L + RING_OFF, g, S, E, wave);
        if (BOTH(3)) GRID_BAR(3);
    }

    if (IN(4)) {
        PTRS
        pg8::Gemm g{MG, BT4, MR, DM, DM, 0}; pg8::StaticOrder S; S.init(MR, DM, G, bx);
        pg8::EpiOut E{x, ap->out};
        pg8::gemm_phase<pg8::EpiOut, pg8::StaticOrder, PG8_ALIGN, PG8_SP2>(L + RING_OFF, g, S, E, wave);
    }
#undef IN
#undef BOTH
}

extern "C" void kernel_launch(void* const* d_in, const int* in_sizes, int n_in, void* d_out, int out_size, void* d_ws, size_t ws_size, hipStream_t stream) {
    static int grid = 0;
    if (grid == 0) {
        if (n_in != 10 || in_sizes[0] != MR * DM || out_size != MR * DM || ws_size < WS_END) { fprintf(stderr, "kernel_launch: unexpected shapes (n_in %d, in0 %d, out %d, ws %zu); nothing launched\n", n_in, n_in > 0 ? in_sizes[0] : -1, out_size, ws_size); grid = -1; return; }
        int dev = 0, cus = 0, per_cu = 0;
        if (hipGetDevice(&dev) != hipSuccess || hipDeviceGetAttribute(&cus, hipDeviceAttributeMultiprocessorCount, dev) != hipSuccess) { fprintf(stderr, "kernel_launch: device query failed\n"); grid = -1; return; }
        if (hipFuncSetAttribute((const void*)mk_fwd, hipFuncAttributeMaxDynamicSharedMemorySize, LDS_BYTES) != hipSuccess) { fprintf(stderr, "kernel_launch: hipFuncSetAttribute failed\n"); grid = -1; return; }
        if (hipOccupancyMaxActiveBlocksPerMultiprocessor(&per_cu, (const void*)mk_fwd, NWAVES * 64, LDS_BYTES) != hipSuccess || per_cu < 1)
            fprintf(stderr, "kernel_launch: note: occupancy query reports %d workgroups per CU\n", per_cu);
        (void)hipGetLastError();
        grid = cus;
    }
    if (grid < 0) return;
    if (hipMemsetAsync((char*)d_ws + WS_CTL, 0, CTL_ZERO_BYTES, stream) != hipSuccess) { fprintf(stderr, "kernel_launch: hipMemsetAsync failed\n"); return; }
    Args a{};
    for (int i = 0; i < 10; ++i) a.in[i] = (const float*)d_in[i];
    a.out = (float*)d_out; a.ws = (unsigned char*)d_ws;
    const int nl = (DUP_PHASE >= 0) ? 2 : N_LAUNCHES;
    for (int li = 0; li < nl; ++li) {
        if (DUP_PHASE >= 0) { a.ph_lo = li == 0 ? 0 : DUP_PHASE; a.ph_hi = li == 0 ? DUP_PHASE + 1 : PER_PHASE; }
        else if (N_LAUNCHES == PER_PHASE) { a.ph_lo = li; a.ph_hi = li + 1; } else { a.ph_lo = 0; a.ph_hi = PER_PHASE; }
        a.li = li;
        hipLaunchKernelGGL(mk_fwd, dim3(grid), dim3(NWAVES * 64), LDS_BYTES, stream, a);
        const hipError_t le = hipPeekAtLastError();
        if (le != hipSuccess) { fprintf(stderr, "kernel_launch: launch %d failed: %s\n", li, hipGetErrorName(le)); break; }
    }
}
```

```cpp
#include <hip/hip_runtime.h>
#include <cstdio>
#include <cstdint>

#ifndef MK_N_LAUNCHES
#define MK_N_LAUNCHES 1
#endif
#define DUP_PHASE -1

constexpr int BATCH = 2, SEQ = 8192, DM = 1024;
constexpr int LP = SEQ + 128;
constexpr int MP = BATCH * LP;
constexpr int MR = BATCH * SEQ;
constexpr int NPROJ1 = 3328;
constexpr int NGATE = 2048;
constexpr int NPROJ = NPROJ1 + NGATE;
constexpr float RMS_EPS = 1e-6f;
constexpr float LOG2E = 1.4426950408889634f;
constexpr float QSCALE = 0.125f * LOG2E;
constexpr float SB_EPS = 1e-13f;
constexpr int BT_LD = 192;

namespace pg8 {
#define PG8_LAS __attribute__((address_space(3)))
typedef unsigned short bf16_t;
typedef short bf16x8 __attribute__((ext_vector_type(8)));
typedef float f32x4 __attribute__((ext_vector_type(4)));
typedef unsigned u32x4 __attribute__((ext_vector_type(4)));
constexpr int BM = 256, BK = 64, HALF = 128, HTB = HALF * BK * 2  , STAGE_BYTES = 8 * HTB, NXCD = 8, WGM = 8;

__host__ __device__ __forceinline__ int lds_byte(int r, int c) { const int st = (r >> 4) * 2 + (c >> 5), rr = r & 15, cc = c & 31, ob = rr * 64 + cc * 2; return st * 1024 + (ob ^ (((ob >> 9) & 1) << 5)); }
__host__ __device__ __forceinline__ void stage_rc(int b, int& R, int& C) { const int st = b / 1024, sb = b % 1024, swz = sb ^ (((sb >> 9) & 1) << 5); R = (st >> 1) * 16 + swz / 64; C = (st & 1) * 32 + (swz % 64) / 2; }
__host__ __device__ __forceinline__ int perm32(int rho) { const int n = rho >> 4, i = rho & 15; return 8 * (i >> 2) + 4 * n + (i & 3); }

struct Unit { int pm, pn; };
struct Gemm { const bf16_t* A; const bf16_t* Bt; int M, N, K, a_skip; };

struct StaticOrder {
    int nM, nN, nwg, G, c;
    __host__ __device__ void init(int M, int N, int G_, int c_) { nM = M / BM; nN = N / BM; nwg = nM * nN; G = G_; c = c_; }
    __host__ __device__ bool next(int i, Unit& u) const {
        const long L = (long)i * G + c; if (L >= nwg) return false;
        int wgid = (int)L; { const int q = nwg / NXCD, r = nwg % NXCD, xcd = wgid % NXCD, off = wgid / NXCD; wgid = (xcd < r ? xcd * (q + 1) : r * (q + 1) + (xcd - r) * q) + off; }
        const int nig = WGM * nN, gid = wgid / nig, fm = gid * WGM, gsz = (nM - fm) < WGM ? (nM - fm) : WGM;
        u.pm = fm + ((wgid % nig) % gsz); u.pn = (wgid % nig) / gsz; return true;
    }
    __device__ __forceinline__ void a_ready(const Unit&) const {}
    __device__ __forceinline__ void done(const Unit&) const {}
};

struct ListOrder {
    int nM, nN0, nN1, G, c, f0, f1;
    __host__ __device__ static void smap(int nM, int nN, int L, Unit& u) {
        const int nwg = nM * nN; int wgid = L; { const int q = nwg / NXCD, r = nwg % NXCD, xcd = wgid % NXCD, off = wgid / NXCD; wgid = (xcd < r ? xcd * (q + 1) : r * (q + 1) + (xcd - r) * q) + off; }
        const int nig = WGM * nN, gid = wgid / nig, fm = gid * WGM, gsz = (nM - fm) < WGM ? (nM - fm) : WGM;
        u.pm = fm + ((wgid % nig) % gsz); u.pn = (wgid % nig) / gsz;
    }
    __host__ __device__ bool next(int i, Unit& u) const {
        const int f = f0 + c + i * G; if (f >= f1) return false;
        const int n0 = nM * nN0;
        if (f < n0) smap(nM, nN0, f, u); else { smap(nM, nN1, f - n0, u); u.pn += nN0; }
        return true;
    }
    __device__ __forceinline__ void a_ready(const Unit&) const {}
    __device__ __forceinline__ void done(const Unit&) const {}
};

typedef float f32x2_t __attribute__((ext_vector_type(2))); typedef __bf16 bf16x2_t __attribute__((ext_vector_type(2)));
__device__ __forceinline__ unsigned cvt_pk_bf16(float lo, float hi) { f32x2_t v = {lo, hi}; bf16x2_t b = __builtin_convertvector(v, bf16x2_t); return __builtin_bit_cast(unsigned, b); }
__device__ __forceinline__ float bf_lo(unsigned w) { return __uint_as_float(w << 16); }
__device__ __forceinline__ float bf_hi(unsigned w) { return __uint_as_float(w & 0xffff0000u); }
__device__ __forceinline__ float sigmoidf_fast(float v) { return __builtin_amdgcn_rcpf(1.0f + __builtin_amdgcn_exp2f(-v * LOG2E)); }


struct EpiProj {
    static constexpr bool PERM = true, AFTER_DRAIN = false, MID = false, INIT = false;
    bf16_t *QA, *KA, *VA, *SZ, *QB, *KB, *VB, *GS; const float* qgain; const float* kgain;
    __device__ __forceinline__ void mid(f32x4 (&)[2][2][4][2], const Unit&, int, int, int, int) const {}
    __device__ __forceinline__ void operator()(const f32x4 (&acc)[2][2][4][2], const Unit& u, int wr, int wc, int fr, int fq) const {
        const int pn = u.pn;
        int kind; bf16_t* base = nullptr; int head = 0, H = 8; float sc = 1.f; const float* gain = nullptr;
        if (pn < 2)       { kind = 0; base = QA; head = 4 * pn + wc; sc = QSCALE; }
        else if (pn < 4)  { kind = 0; base = KA; head = 4 * (pn - 2) + wc; }
        else if (pn < 6)  { kind = 0; base = VA; head = 4 * (pn - 4) + wc; }
        else if (pn < 8)  { kind = 1; base = SZ; head = 4 * (pn - 6) + wc; H = 16; }
        else if (pn < 10) { kind = 2; base = QB; head = 4 * (pn - 8) + wc; gain = qgain; sc = QSCALE; }
        else if (pn == 10) { H = 2; if (wc < 2) { kind = 2; base = KB; head = wc; gain = kgain; } else { kind = 0; base = VB; head = wc - 2; } }
        else if (pn < 13) { kind = 1; base = SZ; head = 8 + 4 * (pn - 11) + wc; H = 16; }
        else              { kind = 4; base = GS; }
        kind = __builtin_amdgcn_readfirstlane(kind);
#pragma unroll
        for (int ai = 0; ai < 2; ++ai)
#pragma unroll
            for (int m = 0; m < 4; ++m) {
                const int row = u.pm * BM + ai * HALF + wr * 64 + m * 16 + fr;
                const int b = row >= LP ? 1 : 0, pos = row - b * LP;
                f32x4 v[2][2];
#pragma unroll
                for (int bj = 0; bj < 2; ++bj)
#pragma unroll
                    for (int n = 0; n < 2; ++n) v[bj][n] = acc[ai][bj][m][n];
                bf16_t* rowp;
                if (kind == 4) {
                    rowp = (bf16_t*)((char*)base + (unsigned)(((b * SEQ + pos - 128) * NGATE + 256 * (pn - 13) + 64 * wc + 8 * fq) * 2));
#pragma unroll
                    for (int bj = 0; bj < 2; ++bj)
#pragma unroll
                        for (int n = 0; n < 2; ++n)
#pragma unroll
                            for (int e = 0; e < 4; ++e) v[bj][n][e] = fmaxf(sigmoidf_fast(v[bj][n][e]), 1e-30f);
                } else {
                    rowp = (bf16_t*)((char*)base + (unsigned)((((b * H + head) * LP + pos) * 64 + 8 * fq) * 2));
                    if (kind == 1) {
#pragma unroll
                        for (int bj = 0; bj < 2; ++bj)
#pragma unroll
                            for (int n = 0; n < 2; ++n)
#pragma unroll
                                for (int e = 0; e < 4; ++e) { const float x = v[bj][n][e]; v[bj][n][e] = x * sigmoidf_fast(x); }
                    } else if (kind == 2) {
                        float ss = 0.f;
#pragma unroll
                        for (int bj = 0; bj < 2; ++bj)
#pragma unroll
                            for (int n = 0; n < 2; ++n) { const f32x4 x = v[bj][n]; ss += (x[0] * x[0] + x[1] * x[1]) + (x[2] * x[2] + x[3] * x[3]); }
                        ss += __shfl_xor(ss, 16); ss += __shfl_xor(ss, 32);
                        const float inv = sc / sqrtf(ss * (1.0f / 64.0f) + RMS_EPS);
#pragma unroll
                        for (int bj = 0; bj < 2; ++bj)
#pragma unroll
                            for (int n = 0; n < 2; ++n) v[bj][n] = v[bj][n] * *(const f32x4*)(gain + 32 * bj + 8 * fq + 4 * n) * inv;
                    } else {
#pragma unroll
                        for (int bj = 0; bj < 2; ++bj)
#pragma unroll
                            for (int n = 0; n < 2; ++n) v[bj][n] = v[bj][n] * sc;
                    }
                }
                if (kind != 4 || pos >= 128) {
#pragma unroll
                    for (int bj = 0; bj < 2; ++bj) {
                        u32x4 w; w.x = cvt_pk_bf16(v[bj][0][0], v[bj][0][1]); w.y = cvt_pk_bf16(v[bj][0][2], v[bj][0][3]); w.z = cvt_pk_bf16(v[bj][1][0], v[bj][1][1]); w.w = cvt_pk_bf16(v[bj][1][2], v[bj][1][3]);
                        if (kind == 4) __builtin_nontemporal_store(w, (u32x4*)(rowp + 32 * bj)); else *(u32x4*)(rowp + 32 * bj) = w;
                    }
                }
            }
    }
};

struct EpiMerge {
    static constexpr bool PERM = true, AFTER_DRAIN = false, MID = true, INIT = false;
    const bf16_t* GS; bf16_t* MG;
    __device__ __forceinline__ void mid(f32x4 (&acc)[2][2][4][2], const Unit& u, int wr, int wc, int fr, int fq) const {
        const int colbase = 256 * u.pn + 64 * wc + 8 * fq;
#pragma unroll
        for (int ai = 0; ai < 2; ++ai)
#pragma unroll
            for (int m = 0; m < 4; ++m) {
                const int row = u.pm * BM + ai * HALF + wr * 64 + m * 16 + fr;
                const bf16_t* gp = (const bf16_t*)((const char*)GS + (unsigned)((row * NGATE + colbase) * 2));
#pragma unroll
                for (int bj = 0; bj < 2; ++bj) {
                    const u32x4 ga = *(const u32x4*)(gp + 32 * bj), gb = *(const u32x4*)(gp + 1024 + 32 * bj);
                    acc[ai][bj][m][0][0] *= bf_lo(ga.x) * __builtin_amdgcn_rcpf(bf_lo(gb.x)); acc[ai][bj][m][0][1] *= bf_hi(ga.x) * __builtin_amdgcn_rcpf(bf_hi(gb.x));
                    acc[ai][bj][m][0][2] *= bf_lo(ga.y) * __builtin_amdgcn_rcpf(bf_lo(gb.y)); acc[ai][bj][m][0][3] *= bf_hi(ga.y) * __builtin_amdgcn_rcpf(bf_hi(gb.y));
                    acc[ai][bj][m][1][0] *= bf_lo(ga.z) * __builtin_amdgcn_rcpf(bf_lo(gb.z)); acc[ai][bj][m][1][1] *= bf_hi(ga.z) * __builtin_amdgcn_rcpf(bf_hi(gb.z));
                    acc[ai][bj][m][1][2] *= bf_lo(ga.w) * __builtin_amdgcn_rcpf(bf_lo(gb.w)); acc[ai][bj][m][1][3] *= bf_hi(ga.w) * __builtin_amdgcn_rcpf(bf_hi(gb.w));
                }
            }
    }
    __device__ __forceinline__ void operator()(const f32x4 (&acc)[2][2][4][2], const Unit& u, int wr, int wc, int fr, int fq) const {
        const int colbase = 256 * u.pn + 64 * wc + 8 * fq;
#pragma unroll
        for (int ai = 0; ai < 2; ++ai)
#pragma unroll
            for (int m = 0; m < 4; ++m) {
                const int row = u.pm * BM + ai * HALF + wr * 64 + m * 16 + fr;
                const bf16_t* gp = (const bf16_t*)((const char*)GS + (unsigned)((row * NGATE + 1024 + colbase) * 2));
                bf16_t* rowp = (bf16_t*)((char*)MG + (unsigned)((row * DM + colbase) * 2));
#pragma unroll
                for (int bj = 0; bj < 2; ++bj) {
                    const u32x4 gb = *(const u32x4*)(gp + 32 * bj);
                    u32x4 w;
                    w.x = cvt_pk_bf16(acc[ai][bj][m][0][0] * bf_lo(gb.x), acc[ai][bj][m][0][1] * bf_hi(gb.x));
                    w.y = cvt_pk_bf16(acc[ai][bj][m][0][2] * bf_lo(gb.y), acc[ai][bj][m][0][3] * bf_hi(gb.y));
                    w.z = cvt_pk_bf16(acc[ai][bj][m][1][0] * bf_lo(gb.z), acc[ai][bj][m][1][1] * bf_hi(gb.z));
                    w.w = cvt_pk_bf16(acc[ai][bj][m][1][2] * bf_lo(gb.w), acc[ai][bj][m][1][3] * bf_hi(gb.w));
                    *(u32x4*)(rowp + 32 * bj) = w;
                }
            }
    }
};

struct EpiOut {
    static constexpr bool PERM = false, AFTER_DRAIN = false, MID = false, INIT = true;
    const float* X; float* O;
    __device__ __forceinline__ void mid(f32x4 (&)[2][2][4][2], const Unit&, int, int, int, int) const {}
    __device__ __forceinline__ void init(f32x4 (&acc)[2][2][4][2], const Unit& u, int wr, int wc, int fr, int fq) const {
        const int colbase = 256 * u.pn + 64 * wc + 4 * fq;
#pragma unroll
        for (int ai = 0; ai < 2; ++ai)
#pragma unroll
            for (int m = 0; m < 4; ++m) {
                const unsigned off = (unsigned)(((u.pm * BM + ai * HALF + wr * 64 + m * 16 + fr) * DM + colbase) * 4);
#pragma unroll
                for (int bj = 0; bj < 2; ++bj)
#pragma unroll
                    for (int n = 0; n < 2; ++n) acc[ai][bj][m][n] = __builtin_nontemporal_load((const f32x4*)((const char*)X + off + (32 * bj + 16 * n) * 4));
            }
    }
    __device__ __forceinline__ void operator()(const f32x4 (&acc)[2][2][4][2], const Unit& u, int wr, int wc, int fr, int fq) const {
        const int colbase = 256 * u.pn + 64 * wc + 4 * fq;
#pragma unroll
        for (int ai = 0; ai < 2; ++ai)
#pragma unroll
            for (int m = 0; m < 4; ++m) {
                const unsigned off = (unsigned)(((u.pm * BM + ai * HALF + wr * 64 + m * 16 + fr) * DM + colbase) * 4);
#pragma unroll
                for (int bj = 0; bj < 2; ++bj)
#pragma unroll
                    for (int n = 0; n < 2; ++n) __builtin_nontemporal_store(acc[ai][bj][m][n], (f32x4*)((char*)O + off + (32 * bj + 16 * n) * 4));
            }
    }
};

template <class Epi, class Sched, bool ALIGN_EPI = false, bool SP2 = false>
__device__ __forceinline__ void gemm_phase(PG8_LAS unsigned char* lds, const Gemm g, const Sched& S, const Epi& E, int wid  ) {
    const int lane = (int)__builtin_amdgcn_mbcnt_hi(~0u, __builtin_amdgcn_mbcnt_lo(~0u, 0u)), tid = wid * 64 + lane, wr = wid >> 2, wc = wid & 3, fr = lane & 15, fq = lane >> 4;
    const int K = g.K, nt = K / BK;
    unsigned voffA[2], voffB[2];
#pragma unroll
    for (int i = 0; i < 2; ++i) { int R, C; stage_rc(tid * 16 + i * 8192, R, C); const int Rb = Epi::PERM ? ((R & ~31) + perm32(R & 31)) : R;
        voffA[i] = (unsigned)(R * K + C) * 2u; voffB[i] = (unsigned)(Rb * K + C) * 2u; }
    const size_t kstep = (size_t)(BK * 2);
    const size_t hstep = (size_t)HALF * K * 2;
    const size_t tstep = 2 * hstep;
    const size_t rstep = (size_t)K * 2;
    const unsigned ldsw = (unsigned)wid * 1024u;
    const int aoff = lds_byte(wr * 64 + fr, fq * 8), boff = lds_byte(wc * 32 + fr, fq * 8);
#define PG8_AROW(pm) ((size_t)(pm) * BM + (size_t)g.a_skip * (size_t)((pm) / 32 + 1))
#define PG8_SA(b, h) (((b) * 2 + (h)) * HTB)
#define PG8_SB(b, h) ((4 + (b) * 2 + (h)) * HTB)
#define PG8_STAGE(bufoff, gbase, voff) do { _Pragma("unroll") for (int _i = 0; _i < 2; ++_i) \
        __builtin_amdgcn_global_load_lds((const unsigned*)((const char*)(gbase) + (voff)[_i]), (PG8_LAS unsigned*)(lds + (bufoff) + ldsw + _i * 8192), 16, 0, 0); } while (0)
#define PG8_LDA(dst, b, h) do { _Pragma("unroll") for (int m = 0; m < 4; ++m) _Pragma("unroll") for (int k = 0; k < 2; ++k) dst[m][k] = *(const PG8_LAS bf16x8*)(lds + PG8_SA(b, h) + aoff + m * 2048 + k * 1024); } while (0)
#define PG8_LDB(dst, b, h) do { _Pragma("unroll") for (int n = 0; n < 2; ++n) _Pragma("unroll") for (int k = 0; k < 2; ++k) dst[n][k] = *(const PG8_LAS bf16x8*)(lds + PG8_SB(b, h) + boff + n * 2048 + k * 1024); } while (0)
#define PG8_MMA(ai, bj, At, Bt) do { __builtin_amdgcn_s_setprio(1); _Pragma("unroll") for (int m = 0; m < 4; ++m) _Pragma("unroll") for (int n = 0; n < 2; ++n) _Pragma("unroll") for (int k = 0; k < 2; ++k) \
        acc[ai][bj][m][n] = __builtin_amdgcn_mfma_f32_16x16x32_bf16(Bt[n][k], At[m][k], acc[ai][bj][m][n], 0, 0, 0); __builtin_amdgcn_s_setprio(0); } while (0)
#define PG8_WAIT_V(n) asm volatile("s_waitcnt vmcnt(" #n ")" ::: "memory")
#define PG8_WAIT_L(n) asm volatile("s_waitcnt lgkmcnt(" #n ")" ::: "memory")
#define PG8_BAR __builtin_amdgcn_s_barrier()
#define PG8_SCHED __builtin_amdgcn_sched_barrier(0)
    Unit cur, nxt; int ui = 0;
    if (!S.next(0, cur)) return;
    f32x4 acc[2][2][4][2];
    if constexpr (Epi::INIT) E.init(acc, cur, wr, wc, fr, fq);
    else {
#pragma unroll
    for (int a = 0; a < 2; ++a)
#pragma unroll
        for (int b = 0; b < 2; ++b)
#pragma unroll
            for (int m = 0; m < 4; ++m)
#pragma unroll
                for (int n = 0; n < 2; ++n) acc[a][b][m][n] = (f32x4){0.f, 0.f, 0.f, 0.f};
    }
    bf16x8 At[4][2], B0[2][2], B1[2][2];
    const char* cA = (const char*)g.A + PG8_AROW(cur.pm) * rstep; const char* cB = (const char*)g.Bt + (size_t)cur.pn * tstep;
    S.a_ready(cur);
    if constexpr (SP2) {
        PG8_STAGE(PG8_SB(0, 0), cB, voffB); PG8_STAGE(PG8_SB(0, 1), cB + hstep, voffB); PG8_STAGE(PG8_SA(0, 0), cA, voffA); PG8_STAGE(PG8_SA(0, 1), cA + hstep, voffA);
        if (wr == 1) PG8_BAR;
        PG8_WAIT_V(2); PG8_BAR;
        PG8_STAGE(PG8_SB(1, 0), cB + kstep, voffB); PG8_STAGE(PG8_SA(1, 0), cA + kstep, voffA); PG8_STAGE(PG8_SB(1, 1), cB + hstep + kstep, voffB);
        PG8_WAIT_V(6); PG8_BAR;
    } else {
        PG8_STAGE(PG8_SB(0, 0), cB, voffB); PG8_STAGE(PG8_SA(0, 0), cA, voffA); PG8_STAGE(PG8_SB(0, 1), cB + hstep, voffB); PG8_STAGE(PG8_SA(0, 1), cA + hstep, voffA);
        if (wr == 1) PG8_BAR;
        PG8_WAIT_V(4); PG8_BAR;
        PG8_STAGE(PG8_SB(1, 0), cB + kstep, voffB); PG8_STAGE(PG8_SA(1, 0), cA + kstep, voffA); PG8_STAGE(PG8_SB(1, 1), cB + hstep + kstep, voffB);
        PG8_WAIT_V(6); PG8_BAR;
    }
    for (;;) {
        const bool has_next = S.next(ui + 1, nxt);
        const char* nA = has_next ? (const char*)g.A + PG8_AROW(nxt.pm) * rstep : cA; const char* nB = has_next ? (const char*)g.Bt + (size_t)nxt.pn * tstep : cB;
        for (int t = 0; t < nt; t += 2) {
            if constexpr (Epi::MID) { if (t == (nt >> 1)) E.mid(acc, cur, wr, wc, fr, fq); }
            const bool last = (t == nt - 2);
            const char* a1 = cA + (size_t)(t + 1) * kstep;
            const char* a2 = last ? nA : cA + (size_t)(t + 2) * kstep; const char* b2 = last ? nB : cB + (size_t)(t + 2) * kstep;
            const char* a3 = a2 + kstep; const char* b3 = b2 + kstep;
            if (last && has_next) S.a_ready(nxt);
            if constexpr (SP2) {
            PG8_LDB(B0, 0, 0); PG8_LDB(B1, 0, 1); PG8_SCHED; PG8_LDA(At, 0, 0); PG8_STAGE(PG8_SA(1, 1), a1 + hstep, voffA);
            PG8_WAIT_V(8); PG8_WAIT_L(0); PG8_BAR; PG8_MMA(0, 0, At, B0); PG8_MMA(0, 1, At, B1); PG8_BAR; PG8_SCHED;
            PG8_LDA(At, 0, 1); PG8_STAGE(PG8_SB(0, 0), b2, voffB); PG8_STAGE(PG8_SB(0, 1), b2 + hstep, voffB); PG8_STAGE(PG8_SA(0, 0), a2, voffA);
            PG8_WAIT_V(8); PG8_WAIT_L(0); PG8_BAR; PG8_MMA(1, 0, At, B0); PG8_MMA(1, 1, At, B1); PG8_BAR; PG8_SCHED;
            PG8_LDB(B0, 1, 0); PG8_LDB(B1, 1, 1); PG8_SCHED; PG8_LDA(At, 1, 0); PG8_STAGE(PG8_SA(0, 1), a2 + hstep, voffA);
            PG8_WAIT_V(8); PG8_WAIT_L(0); PG8_BAR; PG8_MMA(0, 0, At, B0); PG8_MMA(0, 1, At, B1); PG8_BAR; PG8_SCHED;
            PG8_LDA(At, 1, 1); PG8_STAGE(PG8_SB(1, 0), b3, voffB); PG8_STAGE(PG8_SB(1, 1), b3 + hstep, voffB); PG8_STAGE(PG8_SA(1, 0), a3, voffA);
            PG8_WAIT_V(8); PG8_WAIT_L(0); PG8_BAR; PG8_MMA(1, 0, At, B0); PG8_MMA(1, 1, At, B1); PG8_BAR; PG8_SCHED;
            } else {
            PG8_LDB(B0, 0, 0); PG8_SCHED; PG8_LDA(At, 0, 0); PG8_STAGE(PG8_SA(1, 1), a1 + hstep, voffA);
            PG8_WAIT_L(8); PG8_BAR; PG8_WAIT_L(0); PG8_MMA(0, 0, At, B0); PG8_BAR; PG8_SCHED;
            PG8_LDB(B1, 0, 1); PG8_STAGE(PG8_SB(0, 0), b2, voffB);
            PG8_BAR; PG8_WAIT_L(0); PG8_MMA(0, 1, At, B1); PG8_BAR;
            PG8_LDA(At, 0, 1); PG8_STAGE(PG8_SA(0, 0), a2, voffA);
            PG8_BAR; PG8_WAIT_L(0); PG8_MMA(1, 0, At, B0); PG8_BAR; PG8_SCHED;
            PG8_STAGE(PG8_SB(0, 1), b2 + hstep, voffB);
            PG8_WAIT_V(6); PG8_BAR; PG8_MMA(1, 1, At, B1); PG8_BAR;
            PG8_LDB(B0, 1, 0); PG8_SCHED; PG8_LDA(At, 1, 0); PG8_STAGE(PG8_SA(0, 1), a2 + hstep, voffA);
            PG8_WAIT_L(8); PG8_BAR; PG8_WAIT_L(0); PG8_MMA(0, 0, At, B0); PG8_BAR; PG8_SCHED;
            PG8_LDB(B1, 1, 1); PG8_STAGE(PG8_SB(1, 0), b3, voffB);
            PG8_BAR; PG8_WAIT_L(0); PG8_MMA(0, 1, At, B1); PG8_BAR;
            PG8_LDA(At, 1, 1); PG8_STAGE(PG8_SA(1, 0), a3, voffA);
            PG8_BAR; PG8_WAIT_L(0); PG8_MMA(1, 0, At, B0); PG8_BAR; PG8_SCHED;
            PG8_STAGE(PG8_SB(1, 1), b3 + hstep, voffB);
            PG8_WAIT_V(6); PG8_BAR; PG8_MMA(1, 1, At, B1); PG8_BAR;
            }
        }
        if constexpr (ALIGN_EPI) { if (wr == 0) PG8_BAR; }
        E(acc, cur, wr, wc, fr, fq); S.done(cur);
        if (!has_next) break;
        if constexpr (Epi::INIT) E.init(acc, nxt, wr, wc, fr, fq);
        else {
#pragma unroll
        for (int a = 0; a < 2; ++a)
#pragma unroll
            for (int b = 0; b < 2; ++b)
#pragma unroll
                for (int m = 0; m < 4; ++m)
#pragma unroll
                    for (int n = 0; n < 2; ++n) acc[a][b][m][n] = (f32x4){0.f, 0.f, 0.f, 0.f};
        }
        cur = nxt; cA = nA; cB = nB; ++ui;
        if constexpr (ALIGN_EPI) { if (wr == 1) PG8_BAR; }
    }
    PG8_WAIT_V(0);
    if constexpr (!ALIGN_EPI) { if (wr == 0) PG8_BAR; }
    PG8_BAR;
#undef PG8_AROW
#undef PG8_SA
#undef PG8_SB
#undef PG8_STAGE
#undef PG8_LDA
#undef PG8_LDB
#undef PG8_MMA
#undef PG8_WAIT_V
#undef PG8_WAIT_L
#undef PG8_BAR
#undef PG8_SCHED
}
}

#ifndef PG8_SP2
#define PG8_SP2 true
#endif
#ifndef PG8_ALIGN
#define PG8_ALIGN true
#endif

namespace att {
typedef unsigned short bf16_t;
typedef short bf16x8 __attribute__((ext_vector_type(8)));
typedef short s16x4 __attribute__((ext_vector_type(4)));
typedef float f32x16 __attribute__((ext_vector_type(16)));
typedef float f32x4 __attribute__((ext_vector_type(4)));
typedef unsigned u32x4 __attribute__((ext_vector_type(4)));
typedef float f32x2_t __attribute__((ext_vector_type(2))); typedef __bf16 bf16x2_t __attribute__((ext_vector_type(2)));
typedef __attribute__((address_space(3))) unsigned char lds_u8;
typedef __attribute__((address_space(3))) const float lds_cf32;
typedef short v4i16_t __attribute__((ext_vector_type(4)));
__device__ __forceinline__ unsigned cvtpk(float lo, float hi) { f32x2_t v = {lo, hi}; bf16x2_t b = __builtin_convertvector(v, bf16x2_t); return __builtin_bit_cast(unsigned, b); }
__device__ __forceinline__ float bf_lo(unsigned w) { return __uint_as_float(w << 16); }
__device__ __forceinline__ float bf_hi(unsigned w) { return __uint_as_float(w & 0xffff0000u); }
__device__ __forceinline__ s16x4 vtr(const lds_u8* p) { return __builtin_bit_cast(s16x4, __builtin_amdgcn_ds_read_tr16_b64_v4i16((__attribute__((address_space(3))) v4i16_t*)p)); }

constexpr int WAVE_LDS = 16384;
constexpr int OST_PITCH = 272;

struct Tensors {
    const bf16_t *QA, *KA, *VA, *QB, *KB, *VB, *SZ; bf16_t* BR; const float* sinks;
};
struct LaneK {
    int lane, c, hi;
    unsigned kw[4], vw[4];
    unsigned kr[4];
    unsigned vr[2];
    __device__ __forceinline__ void init(int lane_) {
        lane = lane_; c = lane & 31; hi = lane >> 5;
#pragma unroll
        for (int i = 0; i < 4; ++i) {
            const int row = 8 * i + (lane >> 3), ch = lane & 7;
            kw[i] = (unsigned)(row * 128 + ((ch ^ ((row >> 1) & 7)) << 4));
            vw[i] = (unsigned)(row * 128 + ((ch ^ (((row >> 1) & 1) << 2)) << 4));
        }
#pragma unroll
        for (int s = 0; s < 4; ++s) kr[s] = (unsigned)(c * 128 + ((((2 * s + hi)) ^ ((c >> 1) & 7)) << 4));
        const int cg = (lane >> 4) & 1, q = (lane & 15) >> 2, p = lane & 3, qb = (q >> 1) & 1;
#pragma unroll
        for (int dh = 0; dh < 2; ++dh) vr[dh] = (unsigned)((4 * hi + q) * 128 + ((4 * (dh ^ qb) + 2 * cg + (p >> 1)) << 4) + (p & 1) * 8);
    }
};

__device__ __forceinline__ void pack_p(const f32x16& w, bf16x8& p0, bf16x8& p1) {
    u32x4 a, b;
    a.x = cvtpk(w[0], w[1]); a.y = cvtpk(w[2], w[3]); a.z = cvtpk(w[4], w[5]); a.w = cvtpk(w[6], w[7]);
    b.x = cvtpk(w[8], w[9]); b.y = cvtpk(w[10], w[11]); b.z = cvtpk(w[12], w[13]); b.w = cvtpk(w[14], w[15]);
    p0 = __builtin_bit_cast(bf16x8, a); p1 = __builtin_bit_cast(bf16x8, b);
}
__device__ __forceinline__ void load_tile(u32x4 (&r)[4], const bf16_t* p) {
#pragma unroll
    for (int i = 0; i < 4; ++i) r[i] = *(const u32x4*)(p + i * 512);
}
__device__ __forceinline__ void put_tile(lds_u8* buf, const unsigned (&off)[4], const u32x4 (&r)[4]) {
#pragma unroll
    for (int i = 0; i < 4; ++i) *(__attribute__((address_space(3))) u32x4*)(buf + off[i]) = r[i];
}
__device__ __forceinline__ f32x16 qk_tile(const lds_u8* kbuf, const LaneK& L, const bf16x8 (&qf)[4]) {
    f32x16 S = {};
#pragma unroll
    for (int s = 0; s < 4; ++s) {
        const bf16x8 kf = *(const __attribute__((address_space(3))) bf16x8*)(kbuf + L.kr[s]);
        S = __builtin_amdgcn_mfma_f32_32x32x16_bf16(kf, qf[s], S, 0, 0, 0);
    }
    return S;
}
__device__ __forceinline__ void pv_tile(const lds_u8* vbuf, const LaneK& L, const f32x16& w, f32x16& o0, f32x16& o1) {
    bf16x8 pb[2]; pack_p(w, pb[0], pb[1]);
#pragma unroll
    for (int dh = 0; dh < 2; ++dh)
#pragma unroll
        for (int s = 0; s < 2; ++s) {
            const s16x4 lo = vtr(vbuf + L.vr[dh] + (16 * s) * 128), hi4 = vtr(vbuf + L.vr[dh] + (16 * s + 8) * 128);
            const bf16x8 vf = (bf16x8){lo[0], lo[1], lo[2], lo[3], hi4[0], hi4[1], hi4[2], hi4[3]};
            if (dh == 0) o0 = __builtin_amdgcn_mfma_f32_32x32x16_bf16(vf, pb[s], o0, 0, 0, 0);
            else         o1 = __builtin_amdgcn_mfma_f32_32x32x16_bf16(vf, pb[s], o1, 0, 0, 0);
        }
}
__device__ __forceinline__ void write_out(lds_u8* st, const LaneK& L, const f32x16& o0, const f32x16& o1, float scale, const u32x4 (&sz)[4], bf16_t* brp) {
#pragma unroll
    for (int dh = 0; dh < 2; ++dh)
#pragma unroll
        for (int g = 0; g < 4; ++g) {
            const f32x16& o = dh ? o1 : o0;
            const f32x4 v = {o[4 * g] * scale, o[4 * g + 1] * scale, o[4 * g + 2] * scale, o[4 * g + 3] * scale};
            *(__attribute__((address_space(3))) f32x4*)(st + L.c * OST_PITCH + (32 * dh + 8 * g + 4 * L.hi) * 4) = v;
        }
#pragma unroll
    for (int i = 0; i < 4; ++i) {
        const int row = 8 * i + (L.lane >> 3), ch = L.lane & 7;
        const f32x4 a = *(const __attribute__((address_space(3))) f32x4*)(st + row * OST_PITCH + ch * 32);
        const f32x4 b = *(const __attribute__((address_space(3))) f32x4*)(st + row * OST_PITCH + ch * 32 + 16);
        u32x4 w;
        w.x = cvtpk(a[0] * bf_lo(sz[i].x), a[1] * bf_hi(sz[i].x)); w.y = cvtpk(a[2] * bf_lo(sz[i].y), a[3] * bf_hi(sz[i].y));
        w.z = cvtpk(b[0] * bf_lo(sz[i].z), b[1] * bf_hi(sz[i].z)); w.w = cvtpk(b[2] * bf_lo(sz[i].w), b[3] * bf_hi(sz[i].w));
        *(u32x4*)(brp + (size_t)row * 1024 + ch * 8) = w;
    }
}

#define SB_TILE(KR, VR) do { \
        lds_u8* kbuf = wb + cur * 8192; lds_u8* vbuf = kbuf + 4096; \
        put_tile(kbuf, L.kw, KR); put_tile(vbuf, L.vw, VR); \
        if (tile > 4) { load_tile(KR, Kt + (size_t)(tile - 2) * 2048); load_tile(VR, Vt + (size_t)(tile - 2) * 2048); } \
        const f32x16 S = qk_tile(kbuf, L, qf); \
          \
        f32x16 beta, om; \
        const int kb = 32 * tile + 4 * hi; \
        if (tile == t0 || tile == 3) { \
            _Pragma("unroll") for (int r = 0; r < 16; ++r) { \
                const int kv = kb + (r & 3) + 8 * (r >> 2); \
                const bool vis = (kv < qpos) && (kv >= 112); \
                float e = __builtin_amdgcn_exp2f(fminf(S[r], 80.f)); \
                e = vis ? e : 0.f; \
                const float rr = __builtin_amdgcn_rcpf(1.0f + e); \
                beta[r] = e * rr; om[r] = rr; \
            } \
        } else { \
            _Pragma("unroll") for (int r = 0; r < 16; ++r) { \
                const float e = __builtin_amdgcn_exp2f(fminf(S[r], 80.f)); \
                const float rr = __builtin_amdgcn_rcpf(1.0f + e); \
                beta[r] = e * rr; om[r] = rr; \
            } \
        } \
          \
        float sfx[16], Tt[4], To[4]; \
        _Pragma("unroll") for (int g = 0; g < 4; ++g) { \
            sfx[4 * g + 3] = 1.f; sfx[4 * g + 2] = om[4 * g + 3]; sfx[4 * g + 1] = sfx[4 * g + 2] * om[4 * g + 2]; sfx[4 * g] = sfx[4 * g + 1] * om[4 * g + 1]; \
            Tt[g] = sfx[4 * g] * om[4 * g]; \
        } \
        _Pragma("unroll") for (int g = 0; g < 4; ++g) To[g] = __shfl_xor(Tt[g], 32); \
        float pref = carry; \
        f32x16 w; \
        _Pragma("unroll") for (int g = 3; g >= 0; --g) { \
            const float T0 = hi ? To[g] : Tt[g], T1 = hi ? Tt[g] : To[g]; \
            const float P1 = pref, P0 = P1 * T1, Pg = hi ? P1 : P0; \
            _Pragma("unroll") for (int j = 0; j < 4; ++j) w[4 * g + j] = beta[4 * g + j] * (Pg * sfx[4 * g + j]); \
            pref = P0 * T0; \
        } \
        carry = pref; \
        pv_tile(vbuf, L, w, o0, o1); \
        stop = (tile <= 3) || !__any(carry >= SB_EPS); \
        --tile; cur ^= 1; \
    } while (0)
__device__ __forceinline__ void item_sb(const Tensors& T, lds_u8* wb, const LaneK& L, int b, int h, int qt) {
    const int c = L.c, hi = L.hi, lane = L.lane;
    const int p0 = 128 + 32 * qt;
    const size_t headrow = (size_t)(b * 8 + h) * LP;
    const bf16_t* Qp = T.QA + (headrow + p0 + c) * 64 + 8 * hi;
    bf16x8 qf[4];
#pragma unroll
    for (int s = 0; s < 4; ++s) qf[s] = *(const bf16x8*)(Qp + 16 * s);
    const bf16_t* Kt = T.KA + headrow * 64 + lane * 8;
    const bf16_t* Vt = T.VA + headrow * 64 + lane * 8;
    const int t0 = p0 >> 5; int tile = t0, cur = 0;
    u32x4 kA[4], vA[4], kB[4], vB[4];
    load_tile(kA, Kt + (size_t)tile * 2048); load_tile(vA, Vt + (size_t)tile * 2048);
    load_tile(kB, Kt + (size_t)(tile - 1) * 2048); load_tile(vB, Vt + (size_t)(tile - 1) * 2048);
    u32x4 sz[4];
    load_tile(sz, T.SZ + ((size_t)(b * 16 + h) * LP + p0) * 64 + lane * 8);
    f32x16 o0 = {}, o1 = {};
    float carry = 1.f;
    const int qpos = p0 + c;
    bool stop = false;
    for (;;) {
        SB_TILE(kA, vA); if (stop) break;
        SB_TILE(kB, vB); if (stop) break;
    }
    write_out(wb, L, o0, o1, 1.f, sz, T.BR + ((size_t)b * SEQ + 32 * qt) * 1024 + h * 64);
}
#undef SB_TILE

__device__ __forceinline__ void item_sw(const Tensors& T, lds_u8* wb, lds_cf32* btl, const LaneK& L, int b, int hq, int qt) {
    const int c = L.c, hi = L.hi, lane = L.lane, kvh = hq >> 2;
    const int p0 = 128 + 32 * qt, kt = p0 >> 5;
    const bf16_t* Qp = T.QB + ((size_t)(b * 8 + hq) * LP + p0 + c) * 64 + 8 * hi;
    bf16x8 qf[4];
#pragma unroll
    for (int s = 0; s < 4; ++s) qf[s] = *(const bf16x8*)(Qp + 16 * s);
    const bf16_t* Kt = T.KB + ((size_t)(b * 2 + kvh) * LP + (size_t)(kt - 4) * 32) * 64 + lane * 8;
    const bf16_t* Vt = T.VB + ((size_t)(b * 2 + kvh) * LP + (size_t)(kt - 4) * 32) * 64 + lane * 8;
    u32x4 reg[3][4];
    load_tile(reg[0], Kt); load_tile(reg[1], Kt + 2048); load_tile(reg[2], Kt + 2 * 2048);
    u32x4 sz[4];
    load_tile(sz, T.SZ + ((size_t)(b * 16 + 8 + hq) * LP + p0) * 64 + lane * 8);
    f32x16 S[5];
#pragma unroll
    for (int ti = 0; ti < 5; ++ti) {
        lds_u8* kbuf = wb + (ti & 1) * 8192;
        put_tile(kbuf, L.kw, reg[ti % 3]);
        const int nx = ti + 3;
        if (nx < 5) load_tile(reg[ti % 3], Kt + (size_t)nx * 2048); else load_tile(reg[ti % 3], Vt + (size_t)(nx - 5) * 2048);
        S[ti] = qk_tile(kbuf, L, qf);
    }
    const float sink2 = T.sinks[hq] * LOG2E;
    lds_cf32* bt = btl + hq * BT_LD + 32 + (c - 4 * hi);
    float mx = sink2;
    const bool lead = kt < 8;
#pragma unroll
    for (int ti = 0; ti < 5; ++ti)
#pragma unroll
        for (int r = 0; r < 16; ++r) {
            const int ko = (r & 3) + 8 * (r >> 2);
            const int relc = 128 - 32 * ti - ko;
            const int rel = relc + c - 4 * hi;
            float l = S[ti][r] + bt[relc];
            if (ti == 0) l = (rel < 128) ? l : -INFINITY;
            if (ti == 4) l = (rel >= 0) ? l : -INFINITY;
            if (lead) { const int kv = 32 * (kt - 4 + ti) + ko + 4 * hi; l = (kv >= 112) ? l : -INFINITY; }
            S[ti][r] = l; mx = fmaxf(mx, l);
        }
    mx = fmaxf(mx, __shfl_xor(mx, 32));
    float sum = 0.f;
#pragma unroll
    for (int ti = 0; ti < 5; ++ti)
#pragma unroll
        for (int r = 0; r < 16; ++r) { const float pv = __builtin_amdgcn_exp2f(S[ti][r] - mx); S[ti][r] = pv; sum += pv; }
    sum += __shfl_xor(sum, 32);
    const float denom = sum + __builtin_amdgcn_exp2f(sink2 - mx);
    f32x16 o0 = {}, o1 = {};
#pragma unroll
    for (int ti = 0; ti < 5; ++ti) {
        lds_u8* vbuf = wb + ((ti + 1) & 1) * 8192 + 4096;
        put_tile(vbuf, L.vw, reg[(ti + 5) % 3]);
        if (ti + 3 < 5) load_tile(reg[(ti + 5) % 3], Vt + (size_t)(ti + 3) * 2048);
        pv_tile(vbuf, L, S[ti], o0, o1);
    }
    write_out(wb, L, o0, o1, 1.0f / denom, sz, T.BR + ((size_t)b * SEQ + 32 * qt) * 1024 + 512 + hq * 64);
}

__device__ __forceinline__ void attn_phase(const Tensors& T, lds_u8* wb, lds_cf32* btl, int bi0, int bi1, int wave, int lane) {
    LaneK L; L.init(lane);
    for (int bi = bi0; bi < bi1; ++bi) {
        const int kind = bi & 1, r = bi >> 1, qt = (r & 31) * 8 + wave, h = (r >> 5) & 7, b = r >> 8;
        if (kind == 0) item_sb(T, wb, L, b, h, qt); else item_sw(T, wb, btl, L, b, h, qt);
    }
}
}

constexpr int NWAVES = 8;
constexpr int N_LAUNCHES = MK_N_LAUNCHES;
constexpr int PER_PHASE = 5;
constexpr int N_BAR_REGIONS = (MK_N_LAUNCHES == PER_PHASE) ? 1 : MK_N_LAUNCHES;

constexpr size_t MiB = 1u << 20;
constexpr size_t WS_CTL = 0, CTL_ZERO_BYTES = 64 * 1024;
constexpr size_t WS_BT1 = 1 * MiB;
constexpr size_t WS_BT3 = 12 * MiB;
constexpr size_t WS_BT4 = 14 * MiB;
constexpr size_t WS_RS = 16 * MiB;
constexpr size_t WS_BTAB = WS_RS + 128 * 1024;
constexpr size_t WS_XB = 17 * MiB;
constexpr size_t WS_QA = 50 * MiB;
constexpr size_t WS_KA = 67 * MiB;
constexpr size_t WS_VTA = 84 * MiB;
constexpr size_t WS_QB = 101 * MiB;
constexpr size_t WS_SZ = 118 * MiB;
constexpr size_t WS_MG = WS_SZ;
constexpr size_t WS_KB = 151 * MiB;
constexpr size_t WS_VTB = 156 * MiB;
constexpr size_t WS_BR = 161 * MiB;
constexpr size_t WS_END = 193 * MiB;
static_assert(WS_BT1 + (size_t)NPROJ * DM * 2 <= WS_BT3 && WS_XB + (size_t)MP * DM * 2 <= WS_QA && WS_QA + (size_t)MP * 512 * 2 <= WS_KA && WS_VTA + (size_t)MP * 512 * 2 <= WS_QB &&
              WS_QB + (size_t)MP * 512 * 2 <= WS_SZ && WS_SZ + (size_t)MP * DM * 2 <= WS_KB && WS_KB + (size_t)MP * 128 * 2 <= WS_VTB &&
              WS_VTB + (size_t)MP * 128 * 2 <= WS_BR && WS_BR + (size_t)MR * DM * 2 <= WS_END, "d_ws map");
constexpr int CW_TMO = 0, CW_CODE = 1;
constexpr int CW_BAR = 4096;

constexpr int RING_OFF = 0, RING_BYTES = 131072;
constexpr int LDSCTL_OFF = RING_BYTES, MISC_OFF = LDSCTL_OFF + 320;
constexpr int BTL_OFF = RING_BYTES + 1024;
constexpr int LDS_BYTES = 147456;
static_assert(MISC_OFF + 128 <= BTL_OFF && BTL_OFF + 8 * BT_LD * 4 <= LDS_BYTES, "LDS map");

#define GAS __attribute__((address_space(1)))
#define LAS __attribute__((address_space(3)))
typedef unsigned short bf16;
typedef unsigned v4u __attribute__((ext_vector_type(4)));
typedef float f32x4 __attribute__((ext_vector_type(4)));
typedef GAS unsigned gu32;
#define RLX_AGENT __ATOMIC_RELAXED, __HIP_MEMORY_SCOPE_AGENT
#define LDS_WAIT() asm volatile("s_waitcnt lgkmcnt(0)" ::: "memory")
#define VM_WAIT() asm volatile("s_waitcnt vmcnt(0)" ::: "memory")
__device__ __forceinline__ unsigned f2bf(float f) { unsigned u = __builtin_bit_cast(unsigned, f); return (u + 0x7fffu + ((u >> 16) & 1u)) >> 16; }
__device__ __forceinline__ unsigned pk2(float lo, float hi) { return f2bf(lo) | (f2bf(hi) << 16); }

#define XB_TMO      128
#define XB_XCNT(j)  (256  + 64 * (j))
#define XB_XSUB(j)  (1280 + 64 * (j))
#define XB_XGEN(j)  (2304 + 64 * (j))
#define XB_TOP      3328
#define XB_TOPGEN   3392
#define XCD_BAR_WORDS 3456
#define XB_SPIN_CAP (1u << 18)

__device__ __forceinline__ unsigned xb_ld(unsigned* p)              { return __hip_atomic_load(p, __ATOMIC_RELAXED, __HIP_MEMORY_SCOPE_AGENT); }
__device__ __forceinline__ unsigned xb_add(unsigned* p, unsigned v) { return __hip_atomic_fetch_add(p, v, __ATOMIC_RELAXED, __HIP_MEMORY_SCOPE_AGENT); }
__device__ __forceinline__ unsigned xb_xcc_id() { return (unsigned)__builtin_amdgcn_s_getreg((3 << 11) | 20) & 0xFu; }
#define XB_SPIN(cond, bar) do { unsigned _sp = 0; while (cond) { __builtin_amdgcn_s_sleep(1); \
    if ((++_sp & 255u) == 0u) { if (xb_ld(&(bar)[XB_TMO])) break; if (_sp > XB_SPIN_CAP) { atomicAdd(&(bar)[XB_TMO], 1u); break; } } } } while (0)

struct XcdBarrier { unsigned* bar; unsigned x; volatile LAS unsigned* st; };

__device__ __forceinline__ XcdBarrier xcd_barrier_post(unsigned* bar, volatile LAS unsigned* st) {
    XcdBarrier b; b.bar = bar; b.x = xb_xcc_id(); b.st = st;
    if (threadIdx.x == 0) (void)xb_add(&bar[XB_XCNT(b.x)], 1u);
    return b;
}
__device__ __forceinline__ void xcd_barrier_complete(unsigned* bar, unsigned x, unsigned& nloc, unsigned& nx) {
    const unsigned G = gridDim.x * gridDim.y * gridDim.z;
    unsigned sum, cnt, mine, sp = 0u;
    for (;;) {
        sum = 0u; cnt = 0u; mine = 0u;
#pragma unroll
        for (unsigned j = 0; j < 16; ++j) { const unsigned c = xb_ld(&bar[XB_XCNT(j)]); sum += c; cnt += (c > 0u) ? 1u : 0u; mine = (j == x) ? c : mine; }
        if (sum == G) break;
        __builtin_amdgcn_s_sleep(1);
        if ((++sp & 255u) == 0u) { if (xb_ld(&bar[XB_TMO])) break; if (sp > XB_SPIN_CAP) { atomicAdd(&bar[XB_TMO], 1u); break; } }
    }
    nloc = mine > 0u ? mine : 1u; nx = cnt > 0u ? cnt : 1u;
}
__device__ __forceinline__ void xcd_barrier(const XcdBarrier& b) {
    asm volatile("s_waitcnt vmcnt(0)" ::: "memory");
    __syncthreads();
    if (threadIdx.x == 0) {
        unsigned* bar = b.bar;
        __builtin_amdgcn_s_waitcnt(0);
        unsigned nloc = b.st[0], nx = b.st[1];
        if (nloc == 0u) { xcd_barrier_complete(bar, b.x, nloc, nx); b.st[0] = nloc; b.st[1] = nx; }
        const unsigned old = xb_add(&bar[XB_XSUB(b.x)], 1u);
        const unsigned gen = old / nloc;
        if (old + 1u == (gen + 1u) * nloc) {
            __builtin_amdgcn_fence(__ATOMIC_RELEASE, "agent");
            asm volatile("s_waitcnt vmcnt(0)" ::: "memory");
            const unsigned og = xb_add(&bar[XB_TOP], 1u);
            const unsigned tg = og / nx;
            if (og + 1u == (tg + 1u) * nx) xb_add(&bar[XB_TOPGEN], 1u);
            else XB_SPIN(xb_ld(&bar[XB_TOPGEN]) == tg, bar);
            __builtin_amdgcn_fence(__ATOMIC_ACQUIRE, "agent");
            xb_add(&bar[XB_XGEN(b.x)], 1u);
            asm volatile("s_waitcnt vmcnt(0)" ::: "memory");
        } else {
            XB_SPIN(xb_ld(&bar[XB_XGEN(b.x)]) == gen, bar);
            __builtin_amdgcn_fence(__ATOMIC_ACQUIRE, "agent");
            asm volatile("s_waitcnt vmcnt(0)" ::: "memory");
        }
    }
    __syncthreads();
}

__device__ __forceinline__ float wave_sum(float v) {
#pragma unroll
    for (int o = 1; o < 64; o <<= 1) v += __shfl_xor(v, o);
    return v;
}
__device__ __forceinline__ void p0_transpose_item(const float* W, const float* kscale, int K, int N, bf16* WT, int ldk, int koff, LAS float* scr, int item, int lane, int gate_n0 = -1) {
    const int nblk = N / 32, kb = item / nblk, nb = item % nblk, k0 = 64 * kb, n0 = 32 * nb;
    const int r8 = lane >> 3, c4 = (lane & 7) * 4;
    f32x4 w[8]; float ks[8];
#pragma unroll
    for (int i = 0; i < 8; ++i) { w[i] = *(const GAS f32x4*)(W + (size_t)(k0 + r8 + 8 * i) * N + n0 + c4); ks[i] = kscale ? kscale[k0 + r8 + 8 * i] : 1.0f; }
#pragma unroll
    for (int i = 0; i < 8; ++i) { LAS float* d = scr + (r8 + 8 * i) * 33 + c4; d[0] = w[i].x * ks[i]; d[1] = w[i].y * ks[i]; d[2] = w[i].z * ks[i]; d[3] = w[i].w * ks[i]; }
    LDS_WAIT(); asm volatile("" ::: "memory");
    const int c = lane & 7;
    const int srow0 = (n0 & ~255) + 128 * ((n0 >> 5) & 1) + 32 * ((n0 >> 6) & 3);
#pragma unroll
    for (int j = 0; j < 4; ++j) { const int n = (lane >> 3) + 8 * j; const LAS float* s = scr + (8 * c) * 33 + n;
        v4u o; o.x = pk2(s[0 * 33], s[1 * 33]); o.y = pk2(s[2 * 33], s[3 * 33]); o.z = pk2(s[4 * 33], s[5 * 33]); o.w = pk2(s[6 * 33], s[7 * 33]);
        *(GAS v4u*)(WT + (size_t)(srow0 + n) * ldk + koff + k0 + 8 * c) = o; }
    LDS_WAIT(); asm volatile("" ::: "memory");
}

struct Args { const float* in[10]; float* out; unsigned char* ws; int ph_lo, ph_hi, li, pad; };
__global__ void __launch_bounds__(NWAVES * 64, 2) mk_fwd(Args args) {
    extern __shared__ __attribute__((aligned(16))) unsigned char lds[];
    LAS unsigned char* const L = (LAS unsigned char*)lds;
    volatile LAS unsigned* const MISC = (volatile LAS unsigned*)(L + MISC_OFF);
    const int tid = threadIdx.x, lane = tid & 63, wave = __builtin_amdgcn_readfirstlane(tid >> 6);
    const int G = gridDim.x; const int bx = blockIdx.x; const int vcu = (G % 8 == 0) ? (bx % 8) * (G / 8) + bx / 8 : bx;
    typedef __attribute__((address_space(4))) const Args CArgs;
    CArgs* ap = (CArgs*)__builtin_amdgcn_kernarg_segment_ptr();
#define PTRS \
    asm volatile("" : "+s"(ap)); \
    unsigned char* const ws = ap->ws; gu32* const ctl = (gu32*)(ws + WS_CTL); (void)ctl; \
    const float* const x = ap->in[0]; const float* const meta = ap->in[1]; const float* const rel_bias = ap->in[2]; const float* const norm_w = ap->in[3]; const float* const w_in = ap->in[4]; \
    const float* const q_gain = ap->in[5]; const float* const k_gain = ap->in[6]; const float* const sinks = ap->in[7]; const float* const w_branch = ap->in[8]; const float* const w_out = ap->in[9]; \
    bf16* const BT1 = (bf16*)(ws + WS_BT1); bf16* const BT3 = (bf16*)(ws + WS_BT3); bf16* const BT4 = (bf16*)(ws + WS_BT4); \
    float* const RS = (float*)(ws + WS_RS); float* const BTAB = (float*)(ws + WS_BTAB); \
    bf16* const XB = (bf16*)(ws + WS_XB); bf16* const QA = (bf16*)(ws + WS_QA); bf16* const KA = (bf16*)(ws + WS_KA); bf16* const VTA = (bf16*)(ws + WS_VTA); bf16* const QB = (bf16*)(ws + WS_QB); \
    bf16* const GS = (bf16*)ap->out; bf16* const SZ = (bf16*)(ws + WS_SZ); bf16* const MG = (bf16*)(ws + WS_MG); bf16* const KB = (bf16*)(ws + WS_KB); bf16* const VTB = (bf16*)(ws + WS_VTB); bf16* const BR = (bf16*)(ws + WS_BR); \
    (void)x; (void)meta; (void)rel_bias; (void)norm_w; (void)w_in; (void)q_gain; (void)k_gain; (void)sinks; (void)w_branch; (void)w_out; (void)BT1; (void)BT3; (void)BT4; (void)RS; (void)BTAB; \
    (void)XB; (void)QA; (void)KA; (void)VTA; (void)QB; (void)GS; (void)SZ; (void)MG; (void)KB; (void)VTB; (void)BR;
    gu32* ctl0; { PTRS; ctl0 = ctl; }
    for (int u = tid; u < (LDS_BYTES - LDSCTL_OFF) / 4; u += NWAVES * 64) ((LAS unsigned*)(L + LDSCTL_OFF))[u] = 0u;
    __syncthreads();
    const int bli = (N_LAUNCHES == PER_PHASE) ? 0 : ap->li;
    XcdBarrier bar; bar.bar = (unsigned*)(ctl0 + CW_BAR) + bli * XCD_BAR_WORDS; bar.x = 0; bar.st = nullptr;
    if (N_LAUNCHES != PER_PHASE) bar = xcd_barrier_post((unsigned*)(ctl0 + CW_BAR) + bli * XCD_BAR_WORDS, MISC + 8);
#define GRID_BAR(seam) do { if (N_LAUNCHES == PER_PHASE) { if (tid == 0) __hip_atomic_store(ctl0 + CW_TMO, 0xBADBA0u | (unsigned)(seam), RLX_AGENT); } else { xcd_barrier(bar); } } while (0)
    const int lo = ap->ph_lo, hi = ap->ph_hi;
#define IN(k) (lo <= (k) && (k) < hi)
#define BOTH(k) (IN(k) && IN((k) + 1))
    const int gw = vcu * NWAVES + wave, NGW = G * NWAVES;

    if (IN(0)) {
        PTRS
        LAS float* scr = (LAS float*)(L + RING_OFF + wave * 16384);
        constexpr int I_IN = (DM / 64) * (NPROJ / 32), I_BR = (512 / 64) * (DM / 32), I_OUT = (DM / 64) * (DM / 32);
        constexpr int NITEMS = I_IN + 2 * I_BR + I_OUT;
        for (int it = gw; it < NITEMS; it += NGW) {
            int r = it;
            if (r < I_IN) { p0_transpose_item(w_in, norm_w, DM, NPROJ, BT1, DM, 0, scr, r, lane, NPROJ1); continue; } r -= I_IN;
            if (r < I_BR) { p0_transpose_item(w_branch, nullptr, 512, DM, BT3, DM, 0, scr, r, lane); continue; } r -= I_BR;
            if (r < I_BR) { p0_transpose_item(w_branch + (size_t)512 * DM, nullptr, 512, DM, BT3, DM, 512, scr, r, lane); continue; } r -= I_BR;
            p0_transpose_item(w_out, nullptr, DM, DM, BT4, DM, 0, scr, r, lane);
        }
        for (int m0 = gw; m0 < MP; m0 += 4 * NGW) {
            f32x4 v[4][4]; float keep[4];
#pragma unroll
            for (int r = 0; r < 4; ++r) {
                const int m = m0 + r * NGW, mm = m < MP ? m : 0;
                const int b = mm >= LP ? 1 : 0, pos = mm - b * LP;
                const bool real = (m < MP) && (pos >= 112);
                const float* src = !real ? x : (pos < 128 ? meta + (size_t)(pos - 112) * DM : x + ((size_t)b * SEQ + (pos - 128)) * DM);
                keep[r] = real ? 1.f : 0.f;
                const GAS f32x4* xr = (const GAS f32x4*)src + lane;
#pragma unroll
                for (int j = 0; j < 4; ++j) v[r][j] = __builtin_nontemporal_load(xr + 64 * j);
            }
#pragma unroll
            for (int r = 0; r < 4; ++r) {
                const int m = m0 + r * NGW;
                float s = 0.f;
#pragma unroll
                for (int j = 0; j < 4; ++j) { if (keep[r] == 0.f) v[r][j] = (f32x4){0.f, 0.f, 0.f, 0.f}; s += (v[r][j].x * v[r][j].x + v[r][j].y * v[r][j].y) + (v[r][j].z * v[r][j].z + v[r][j].w * v[r][j].w); }
                s = wave_sum(s);
                if (m < MP) {
                    const float rs = 1.0f / sqrtf(s * (1.0f / DM) + RMS_EPS);
                    GAS unsigned long long* o8 = (GAS unsigned long long*)(XB + (size_t)m * DM) + lane;
#pragma unroll
                    for (int j = 0; j < 4; ++j) o8[64 * j] = (unsigned long long)pk2(v[r][j].x * rs, v[r][j].y * rs) | ((unsigned long long)pk2(v[r][j].z * rs, v[r][j].w * rs) << 32);
                }
            }
        }
        if (bx == 0) {
            for (int i = tid; i < 8 * BT_LD; i += NWAVES * 64) {
                const int h = i / BT_LD, rel = i % BT_LD - 32;
                float v = 0.f;
                if (rel >= 0 && rel < 128) {
                    int bucket = rel;
                    if (rel >= 16) { int l = 16 + (int)(log2f((float)rel * (1.0f / 16.0f)) * (16.0f / 3.0f)); bucket = l < 31 ? l : 31; }
                    v = rel_bias[bucket * 8 + h] * LOG2E;
                }
                BTAB[i] = v;
            }
        }
        if (BOTH(0)) GRID_BAR(0);
    }

    constexpr int NUNITS = (MP / 256) * (NPROJ / 256), NU0 = (MP / 256) * (NPROJ1 / 256);
    const int F1 = (5 * G >= NU0 && 5 * G <= NUNITS) ? 5 * G : NUNITS;
    if (IN(1)) {
        PTRS
        pg8::Gemm g{XB, BT1, MP, NPROJ, DM, 0}; const pg8::ListOrder S{MP / 256, NPROJ1 / 256, NGATE / 256, G, bx, 0, F1};
        pg8::EpiProj E{QA, KA, VTA, SZ, QB, KB, VTB, GS, q_gain, k_gain};
        pg8::gemm_phase<pg8::EpiProj, pg8::ListOrder, PG8_ALIGN, PG8_SP2>(L + RING_OFF, g, S, E, wave);
        if (BOTH(1)) GRID_BAR(1);
    }

    if (IN(2)) {
        PTRS
        const int tail = NUNITS - F1;
        int bi0, bi1;
        if (G == 256 && tail > 0) { const int n2 = tail % G; if (bx < n2) { bi0 = 2 * bx; bi1 = bi0 + 2; } else { bi0 = 2 * n2 + 5 * (bx - n2); bi1 = bi0 + 5; } }
        else { const int per = (1024 + G - 1) / G; bi0 = bx * per; bi1 = bi0 + per; }
        bi0 = bi0 < 1024 ? bi0 : 1024; bi1 = bi1 < 1024 ? bi1 : 1024;
        {
            LAS float* btl = (LAS float*)(L + BTL_OFF);
            for (int i = tid; i < 8 * BT_LD; i += NWAVES * 64) btl[i] = BTAB[i];
            __syncthreads();
            const att::Tensors T{QA, KA, VTA, QB, KB, VTB, SZ, BR, sinks};
            att::attn_phase(T, L + RING_OFF + wave * att::WAVE_LDS, (att::lds_cf32*)btl, bi0, bi1, wave, lane);
            __syncthreads();
        }
        {
            pg8::Gemm g{XB, BT1, MP, NPROJ, DM, 0}; const pg8::ListOrder S{MP / 256, NPROJ1 / 256, NGATE / 256, G, bx, F1, NUNITS};
            pg8::EpiProj E{QA, KA, VTA, SZ, QB, KB, VTB, GS, q_gain, k_gain};
            pg8::gemm_phase<pg8::EpiProj, pg8::ListOrder, PG8_ALIGN, PG8_SP2>(L + RING_OFF, g, S, E, wave);
        }
        if (BOTH(2)) GRID_BAR(2);
    }

    if (IN(3)) {
        PTRS
        pg8::Gemm g{BR, BT3, MR, DM, DM, 0}; pg8::StaticOrder S; S.init(MR, DM, G, bx);
        pg8::EpiMerge E{GS, MG};
        pg8::gemm_phase<pg8::EpiMerge, pg8::StaticOrder, PG8_ALIGN, PG8_SP2>(L + RING_OFF, g, S, E, wave);
        if (BOTH(3)) GRID_BAR(3);
    }

    if (IN(4)) {
        PTRS
        pg8::Gemm g{MG, BT4, MR, DM, DM, 0}; pg8::StaticOrder S; S.init(MR, DM, G, bx);
        pg8::EpiOut E{x, ap->out};
        pg8::gemm_phase<pg8::EpiOut, pg8::StaticOrder, PG8_ALIGN, PG8_SP2>(L + RING_OFF, g, S, E, wave);
    }
#undef IN
#undef BOTH
}

extern "C" void kernel_launch(void* const* d_in, const int* in_sizes, int n_in, void* d_out, int out_size, void* d_ws, size_t ws_size, hipStream_t stream) {
    static int grid = 0;
    if (grid == 0) {
        if (n_in != 10 || in_sizes[0] != MR * DM || out_size != MR * DM || ws_size < WS_END) { fprintf(stderr, "kernel_launch: unexpected shapes (n_in %d, in0 %d, out %d, ws %zu); nothing launched\n", n_in, n_in > 0 ? in_sizes[0] : -1, out_size, ws_size); grid = -1; return; }
        int dev = 0, cus = 0, per_cu = 0;
        if (hipGetDevice(&dev) != hipSuccess || hipDeviceGetAttribute(&cus, hipDeviceAttributeMultiprocessorCount, dev) != hipSuccess) { fprintf(stderr, "kernel_launch: device query failed\n"); grid = -1; return; }
        if (hipFuncSetAttribute((const void*)mk_fwd, hipFuncAttributeMaxDynamicSharedMemorySize, LDS_BYTES) != hipSuccess) { fprintf(stderr, "kernel_launch: hipFuncSetAttribute failed\n"); grid = -1; return; }
        if (hipOccupancyMaxActiveBlocksPerMultiprocessor(&per_cu, (const void*)mk_fwd, NWAVES * 64, LDS_BYTES) != hipSuccess || per_cu < 1)
            fprintf(stderr, "kernel_launch: note: occupancy query reports %d workgroups per CU\n", per_cu);
        (void)hipGetLastError();
        grid = cus;
    }
    if (grid < 0) return;
    if (hipMemsetAsync((char*)d_ws + WS_CTL, 0, CTL_ZERO_BYTES, stream) != hipSuccess) { fprintf(stderr, "kernel_launch: hipMemsetAsync failed\n"); return; }
    Args a{};
    for (int i = 0; i < 10; ++i) a.in[i] = (const float*)d_in[i];
    a.out = (float*)d_out; a.ws = (unsigned char*)d_ws;
    const int nl = (DUP_PHASE >= 0) ? 2 : N_LAUNCHES;
    for (int li = 0; li < nl; ++li) {
        if (DUP_PHASE >= 0) { a.ph_lo = li == 0 ? 0 : DUP_PHASE; a.ph_hi = li == 0 ? DUP_PHASE + 1 : PER_PHASE; }
        else if (N_LAUNCHES == PER_PHASE) { a.ph_lo = li; a.ph_hi = li + 1; } else { a.ph_lo = 0; a.ph_hi = PER_PHASE; }
        a.li = li;
        hipLaunchKernelGGL(mk_fwd, dim3(grid), dim3(NWAVES * 64), LDS_BYTES, stream, a);
        const hipError_t le = hipPeekAtLastError();
        if (le != hipSuccess) { fprintf(stderr, "kernel_launch: launch %d failed: %s\n", li, hipGetErrorName(le)); break; }
    }
}
```
